# Optimizing an MI355X kernel written in HIP

```python
import math
import jax, jax.numpy as jnp
from jax import lax
import numpy as np

D_MODEL = 1024
BATCH = 8
SEQ = 4096
DEPTH = 2

CHUNK = 64
Q_BLOCK = 128
HEAD_DIM = 64
N_HEADS_SPARSE = 8
N_HEADS_SB = 8
W_SPARSE = N_HEADS_SPARSE * HEAD_DIM
W_SB = N_HEADS_SB * HEAD_DIM
N_IDX_HEADS = 8
IDX_DIM = 64
INDEX_TOPK = 256
N_BUCKETS = 32
MAX_DISTANCE = 128
D_FF = -(-8 * D_MODEL // (3 * 256)) * 256
RMS_EPS = 1e-6
IN_SIZES = (W_SPARSE, W_SPARSE, W_SPARSE,
            N_IDX_HEADS * IDX_DIM, IDX_DIM, N_IDX_HEADS,
            W_SB, W_SB, W_SB,
            D_MODEL, D_MODEL)
IN_WIDTH = sum(IN_SIZES)

kernel_name = 'hybrid_dsa_stickbreaking_block'


def rmsnorm(x, g):
    xf = x.astype(jnp.float32)
    y = xf * lax.rsqrt(jnp.mean(xf * xf, axis=-1, keepdims=True) + RMS_EPS) * g.astype(jnp.float32)
    return y.astype(x.dtype)


def split_columns(p):
    offs = np.cumsum(np.array(IN_SIZES))[:-1].tolist()
    return jnp.split(p, offs, axis=-1)


def t5_bucket(rel):
    nb = N_BUCKETS // 2
    max_exact = nb // 2
    ret = (rel > 0).astype(jnp.int32) * nb
    n = jnp.abs(rel)
    nf = jnp.maximum(n, 1).astype(jnp.float32)
    large = max_exact + (jnp.log(nf / max_exact) / math.log(MAX_DISTANCE / max_exact)
                         * (nb - max_exact)).astype(jnp.int32)
    large = jnp.minimum(large, nb - 1)
    return ret + jnp.where(n < max_exact, n, large)


def sparse_attention(q, k, v, q_idx, k_idx, w_idx, rel_bias):
    B, S, H, dh = q.shape
    top_k = min(INDEX_TOPK, S // 4)
    spos = jnp.arange(S)
    k_idx_f = k_idx.astype(jnp.float32)

    def block(blk):
        t0 = blk * Q_BLOCK
        tpos = t0 + jnp.arange(Q_BLOCK)
        qi = lax.dynamic_slice_in_dim(q_idx, t0, Q_BLOCK, axis=1).astype(jnp.float32)
        wi = lax.dynamic_slice_in_dim(w_idx, t0, Q_BLOCK, axis=1).astype(jnp.float32)
        dots = jax.nn.relu(jnp.einsum('bqhd,bsd->bqhs', qi, k_idx_f) * IDX_DIM ** -0.5)
        score = jnp.einsum('bqhs,bqh->bqs', dots, wi * N_IDX_HEADS ** -0.5)
        admissible = (spos[None, :] // CHUNK) <= (tpos[:, None] // CHUNK)
        score = jnp.where(admissible[None], score, -jnp.inf)
        top_val, top_idx = lax.top_k(score, top_k)
        valid = jnp.isfinite(top_val)
        k_sel = jax.vmap(lambda kb, ib: kb[ib])(k, top_idx).astype(jnp.float32)
        v_sel = jax.vmap(lambda vb, ib: vb[ib])(v, top_idx).astype(jnp.float32)
        qa = lax.dynamic_slice_in_dim(q, t0, Q_BLOCK, axis=1).astype(jnp.float32)
        logits = jnp.einsum('bqhd,bqkhd->bhqk', qa, k_sel) * dh ** -0.5
        rel = top_idx - tpos[None, :, None]
        bias = rel_bias.astype(jnp.float32)[t5_bucket(rel)]
        logits = logits + bias.transpose(0, 3, 1, 2)
        logits = jnp.where(valid[:, None], logits, -jnp.inf)
        p = jax.nn.softmax(logits, axis=-1)
        return jnp.einsum('bhqk,bqkhd->bqhd', p, v_sel).astype(q.dtype)

    o = lax.map(block, jnp.arange(S // Q_BLOCK))
    return o.transpose(1, 0, 2, 3, 4).reshape(B, S, H * dh)


def stick_breaking_attention(q, k, v):
    B, S, H, dh = q.shape
    spos = jnp.arange(S)
    kf = k.astype(jnp.float32)
    vf = v.astype(jnp.float32)

    def block(blk):
        t0 = blk * Q_BLOCK
        tpos = t0 + jnp.arange(Q_BLOCK)
        qb = lax.dynamic_slice_in_dim(q, t0, Q_BLOCK, axis=1).astype(jnp.float32)
        z = jnp.einsum('bqhd,bshd->bhqs', qb, kf) * dh ** -0.5
        causal = (spos[None, :] < tpos[:, None])[None, None]
        log_beta = jax.nn.log_sigmoid(z)
        log_keep = jnp.where(causal, log_beta - z, 0.0)
        between = lax.cumsum(log_keep, axis=3, reverse=True) - log_keep
        a = jnp.where(causal, jnp.exp(log_beta + between), 0.0)
        return jnp.einsum('bhqs,bshd->bqhd', a, vf).astype(q.dtype)

    o = lax.map(block, jnp.arange(S // Q_BLOCK))
    return o.transpose(1, 0, 2, 3, 4).reshape(B, S, H * dh)


def setup_inputs(seed: int = 0) -> dict:
    key = jax.random.key(seed)
    ks = jax.random.split(key, 16)
    f32 = jnp.float32

    def w(k, shape, fan_in):
        return jax.random.normal(k, shape, f32) * fan_in ** -0.5

    def gain(k):
        return 1.0 + 0.05 * jax.random.normal(k, (DEPTH, D_MODEL), f32)

    return {
        'x': jax.random.normal(ks[0], (BATCH, SEQ, D_MODEL), f32),
        'w_in': w(ks[1], (DEPTH, D_MODEL, IN_WIDTH), D_MODEL),
        'w_branch_sparse': w(ks[2], (DEPTH, W_SPARSE, D_MODEL), W_SPARSE),
        'w_branch_sb': w(ks[3], (DEPTH, W_SB, D_MODEL), W_SB),
        'w_out': w(ks[4], (DEPTH, D_MODEL, D_MODEL), D_MODEL),
        'w_gate_up': w(ks[5], (DEPTH, D_MODEL, 2 * D_FF), D_MODEL),
        'w_down': w(ks[6], (DEPTH, D_FF, D_MODEL), D_FF),
        'g_pre_mix': gain(ks[7]),
        'g_post_mix': gain(ks[8]),
        'g_pre_ffn': gain(ks[9]),
        'g_post_ffn': gain(ks[10]),
        'rel_bias': 0.5 * jax.random.normal(ks[11], (N_BUCKETS, N_HEADS_SPARSE), f32),
    }


def reference(x, w_in, w_branch_sparse, w_branch_sb, w_out, w_gate_up, w_down,
              g_pre_mix, g_post_mix, g_pre_ffn, g_post_ffn, rel_bias):
    B, S, _ = x.shape
    for l in range(DEPTH):
        h = rmsnorm(x, g_pre_mix[l])
        proj = h @ w_in[l]
        (qa, ka, va, qi, ki, wi, qb, kb, vb, gate_a, gate_b) = split_columns(proj)
        o_a = sparse_attention(
            qa.reshape(B, S, N_HEADS_SPARSE, HEAD_DIM),
            ka.reshape(B, S, N_HEADS_SPARSE, HEAD_DIM),
            va.reshape(B, S, N_HEADS_SPARSE, HEAD_DIM),
            qi.reshape(B, S, N_IDX_HEADS, IDX_DIM), ki, wi, rel_bias)
        o_b = stick_breaking_attention(
            qb.reshape(B, S, N_HEADS_SB, HEAD_DIM),
            kb.reshape(B, S, N_HEADS_SB, HEAD_DIM),
            vb.reshape(B, S, N_HEADS_SB, HEAD_DIM))
        m = (jax.nn.sigmoid(gate_a) * (o_a @ w_branch_sparse[l])
             + jax.nn.sigmoid(gate_b) * (o_b @ w_branch_sb[l]))
        x = x + rmsnorm(m @ w_out[l], g_post_mix[l])
        h = rmsnorm(x, g_pre_ffn[l])
        g, u = jnp.split(h @ w_gate_up[l], 2, axis=-1)
        x = x + rmsnorm((jax.nn.silu(g) * u) @ w_down[l], g_post_ffn[l])
    return x
```

```cpp
#include <hip/hip_runtime.h>
#include <cstdint>
#include <cstdio>

#define GAS __attribute__((address_space(1)))
#define LAS __attribute__((address_space(3)))
typedef _Float16 f16;
typedef _Float16 f16x8 __attribute__((ext_vector_type(8)));
typedef _Float16 f16x2 __attribute__((ext_vector_type(2)));
typedef _Float16 f16x4 __attribute__((ext_vector_type(4)));
typedef float f32x2 __attribute__((ext_vector_type(2)));
typedef float f32x4 __attribute__((ext_vector_type(4)));
typedef float f32x16 __attribute__((ext_vector_type(16)));
typedef unsigned u32x4 __attribute__((ext_vector_type(4)));
typedef unsigned u32x2 __attribute__((ext_vector_type(2)));
typedef short s16x4 __attribute__((ext_vector_type(4)));
typedef short v4i16_t __attribute__((ext_vector_type(4)));
typedef int i32x8 __attribute__((ext_vector_type(8)));
typedef int i32x4 __attribute__((ext_vector_type(4)));

constexpr int BATCH = 8, SEQ = 4096, DM = 1024, M = BATCH * SEQ, DEPTH = 2;
constexpr int NIN_SRC = 5704, NIN = 5888;
constexpr int DFF = 2816, NGU = 2 * DFF;
constexpr int NH = 8, HD = 64;
constexpr int P_QKV = 1536;
constexpr int P_KI = 64;
constexpr float RMS_EPS = 1e-6f;
constexpr float LOG2E = 1.4426950408889634f;
constexpr float C2A = 0.125f * LOG2E;
constexpr float C2B = 0.125f * LOG2E;
constexpr int TOPK = 256;

constexpr size_t MiB = 1u << 20;
constexpr size_t WS_CTL = 0, CTL_ZERO_BYTES = 1 * MiB;
constexpr size_t WS_WT = 1 * MiB;
constexpr size_t WT_LAYER = 32 * MiB;
constexpr int NIN16 = 3840;
constexpr size_t WT_IN = 0, WT_G8 = WT_IN + (size_t)NIN16 * DM * 2, WT_A = WT_IN + (size_t)NIN * DM * 2, WT_B = WT_A + 1 * MiB, WT_O = WT_B + 1 * MiB, WT_GU = WT_O + 2 * MiB, WT_D = WT_GU + 11 * MiB;
static_assert(WT_D + (size_t)DM * DFF * 2 == WT_LAYER && WT_G8 + (size_t)2048 * DM <= WT_A, "weight map");
constexpr size_t WS_H = 33 * MiB;
constexpr size_t WS_QKVA = 97 * MiB;
constexpr size_t WS_QI = 193 * MiB;
constexpr size_t WS_KIW = 225 * MiB;
constexpr size_t WS_WI = WS_KIW + 4 * MiB;
constexpr size_t WS_QKVB = 233 * MiB;
constexpr size_t WS_GATES = 329 * MiB;
constexpr size_t WS_MASK = 457 * MiB;
constexpr size_t WS_H8 = 473 * MiB;
constexpr size_t WS_END = 505 * MiB;
constexpr size_t WS_HID = WS_QKVA;
static_assert(WS_HID + (size_t)M * DFF * 2 <= WS_GATES, "hid overlay");
constexpr int CW_BAR = 4096;

constexpr int RING_BYTES = 131072;
constexpr int LDS_BYTES = 147456;
constexpr int PHASE_LDS = LDS_BYTES - 256;
constexpr int MISC_OFF = PHASE_LDS;

#define RLX_AGENT __ATOMIC_RELAXED, __HIP_MEMORY_SCOPE_AGENT
#define LDS_WAIT() asm volatile("s_waitcnt lgkmcnt(0)" ::: "memory")
#define VM_WAIT() asm volatile("s_waitcnt vmcnt(0)" ::: "memory")
__device__ __forceinline__ unsigned pk2h(float lo, float hi) { f32x2 v = {lo, hi}; f16x2 h = __builtin_convertvector(v, f16x2); return __builtin_bit_cast(unsigned, h); }
template <int CTRL> __device__ __forceinline__ float dpp_mov(float x) { return __uint_as_float((unsigned)__builtin_amdgcn_update_dpp(0, (int)__float_as_uint(x), CTRL, 0xf, 0xf, false)); }
__device__ __forceinline__ float wave_sum(float v) {
    v += dpp_mov<0xB1>(v); v += dpp_mov<0x4E>(v); v += dpp_mov<0x141>(v); v += dpp_mov<0x140>(v);
    const float r0 = __uint_as_float((unsigned)__builtin_amdgcn_readlane((int)__float_as_uint(v), 0)), r1 = __uint_as_float((unsigned)__builtin_amdgcn_readlane((int)__float_as_uint(v), 16));
    const float r2 = __uint_as_float((unsigned)__builtin_amdgcn_readlane((int)__float_as_uint(v), 32)), r3 = __uint_as_float((unsigned)__builtin_amdgcn_readlane((int)__float_as_uint(v), 48));
    return (r0 + r1) + (r2 + r3);
}
__device__ __forceinline__ float sigmoidf_(float x) { return __builtin_amdgcn_rcpf(1.0f + __builtin_amdgcn_exp2f(-x * LOG2E)); }

#define XB_TMO      128
#define XB_XCNT(j)  (256  + 64 * (j))
#define XB_XSUB(j)  (1280 + 64 * (j))
#define XB_XGEN(j)  (2304 + 64 * (j))
#define XB_TOP      3328
#define XB_TOPGEN   3392
#define XCD_BAR_WORDS 3456
#define XB_SPIN_CAP (1u << 18)
__device__ __forceinline__ unsigned xb_ld(unsigned* p)              { return __hip_atomic_load(p, __ATOMIC_RELAXED, __HIP_MEMORY_SCOPE_AGENT); }
__device__ __forceinline__ unsigned xb_add(unsigned* p, unsigned v) { return __hip_atomic_fetch_add(p, v, __ATOMIC_RELAXED, __HIP_MEMORY_SCOPE_AGENT); }
__device__ __forceinline__ unsigned xb_xcc_id() { return (unsigned)__builtin_amdgcn_s_getreg((3 << 11) | 20) & 0xFu; }
#define XB_SPIN(cond, bar) do { unsigned _sp = 0; while (cond) { __builtin_amdgcn_s_sleep(1); \
    if ((++_sp & 255u) == 0u) { if (xb_ld(&(bar)[XB_TMO])) break; if (_sp > XB_SPIN_CAP) { atomicAdd(&(bar)[XB_TMO], 1u); break; } } } } while (0)
struct XcdBarrier { unsigned* bar; unsigned x; volatile LAS unsigned* st; };
__device__ __forceinline__ XcdBarrier xcd_barrier_post(unsigned* bar, volatile LAS unsigned* st) {
    XcdBarrier b; b.bar = bar; b.x = xb_xcc_id(); b.st = st;
    if (threadIdx.x == 0) (void)xb_add(&bar[XB_XCNT(b.x)], 1u);
    return b;
}
__device__ __forceinline__ void xcd_barrier_complete(unsigned* bar, unsigned x, unsigned& nloc, unsigned& nx) {
    const unsigned G = gridDim.x * gridDim.y * gridDim.z;
    unsigned sum, cnt, mine, sp = 0u;
    for (;;) {
        sum = 0u; cnt = 0u; mine = 0u;
#pragma unroll
        for (unsigned j = 0; j < 16; ++j) { const unsigned c = xb_ld(&bar[XB_XCNT(j)]); sum += c; cnt += (c > 0u) ? 1u : 0u; mine = (j == x) ? c : mine; }
        if (sum == G) break;
        __builtin_amdgcn_s_sleep(1);
        if ((++sp & 255u) == 0u) { if (xb_ld(&bar[XB_TMO])) break; if (sp > XB_SPIN_CAP) { atomicAdd(&bar[XB_TMO], 1u); break; } }
    }
    nloc = mine > 0u ? mine : 1u; nx = cnt > 0u ? cnt : 1u;
}
__device__ __forceinline__ void xcd_barrier(const XcdBarrier& b) {
    asm volatile("s_waitcnt vmcnt(0)" ::: "memory");
    __syncthreads();
    if (threadIdx.x == 0) {
        unsigned* bar = b.bar; unsigned bx = b.x; asm volatile("" : "+s"(bar), "+s"(bx));
        __builtin_amdgcn_s_waitcnt(0);
        unsigned nloc = b.st[0], nx = b.st[1];
        if (nloc == 0u) { xcd_barrier_complete(bar, bx, nloc, nx); b.st[0] = nloc; b.st[1] = nx; }
        const unsigned old = xb_add(&bar[XB_XSUB(bx)], 1u);
        const unsigned gen = old / nloc;
        if (old + 1u == (gen + 1u) * nloc) {
            __builtin_amdgcn_fence(__ATOMIC_RELEASE, "agent");
            asm volatile("s_waitcnt vmcnt(0)" ::: "memory");
            const unsigned og = xb_add(&bar[XB_TOP], 1u);
            const unsigned tg = og / nx;
            if (og + 1u == (tg + 1u) * nx) xb_add(&bar[XB_TOPGEN], 1u);
            else XB_SPIN(xb_ld(&bar[XB_TOPGEN]) == tg, bar);
            __builtin_amdgcn_fence(__ATOMIC_ACQUIRE, "agent");
            xb_add(&bar[XB_XGEN(bx)], 1u);
            asm volatile("s_waitcnt vmcnt(0)" ::: "memory");
        } else {
            XB_SPIN(xb_ld(&bar[XB_XGEN(bx)]) == gen, bar);
            __builtin_amdgcn_fence(__ATOMIC_ACQUIRE, "agent");
            asm volatile("s_waitcnt vmcnt(0)" ::: "memory");
        }
    }
    __syncthreads();
}

namespace pg8 {
constexpr int BM = 256, BK = 64, HALF = 128, HTB = HALF * BK * 2, STAGE_BYTES = 8 * HTB, NXCD = 8, WGM = 8;
__host__ __device__ __forceinline__ int lds_byte(int r, int c) { const int st = (r >> 4) * 2 + (c >> 5), rr = r & 15, cc = c & 31, ob = rr * 64 + cc * 2; return st * 1024 + (ob ^ (((ob >> 9) & 1) << 5)); }
__host__ __device__ __forceinline__ void stage_rc(int b, int& R, int& C) { const int st = b / 1024, sb = b % 1024, swz = sb ^ (((sb >> 9) & 1) << 5); R = (st >> 1) * 16 + swz / 64; C = (st & 1) * 32 + (swz % 64) / 2; }
__host__ __device__ __forceinline__ int perm32(int rho) { const int n = rho >> 4, i = rho & 15; return 8 * (i >> 2) + 4 * n + (i & 3); }
struct Unit { int pm, pn; };
struct Gemm { const f16* A; const f16* Bt; int M, N, K, lda; const f16* A2; int ksplit; };
struct StaticOrder {
    int nM, nN, nwg, G, c;
    __host__ __device__ void init(int M_, int N_, int G_, int c_) { nM = M_ / BM; nN = N_ / BM; nwg = nM * nN; G = G_; c = c_; }
    __host__ __device__ bool next(int i, Unit& u) const {
        const long L = (long)i * G + c; if (L >= nwg) return false;
        int wgid = (int)L; { const int q = nwg / NXCD, r = nwg % NXCD, xcd = wgid % NXCD, off = wgid / NXCD; wgid = (xcd < r ? xcd * (q + 1) : r * (q + 1) + (xcd - r) * q) + off; }
        const int nig = WGM * nN, gid = wgid / nig, fm = gid * WGM, gsz = (nM - fm) < WGM ? (nM - fm) : WGM;
        u.pm = fm + ((wgid % nig) % gsz); u.pn = (wgid % nig) / gsz; return true;
    }
};
struct GateOrder {
    int c;
    __host__ __device__ bool next(int i, Unit& u) const {
        const int x = c & 7, j = c >> 3; int U;
        if (j < 16) { if (i >= 3) return false; U = j + 16 * i; } else { if (i >= 5) return false; U = 48 + (j - 16) + 16 * i; }
        u.pm = 16 * x + (U >> 3); u.pn = U & 7; return true;
    }
};
template <class Epi, bool ALIGN_EPI, bool FP8, class Sched>
__device__ __forceinline__ void gemm_phase_t(LAS unsigned char* lds, const Gemm g, const Sched& S, const Epi& E) {
    int tid = threadIdx.x; asm volatile("" : "+v"(tid));
    const int wid = __builtin_amdgcn_readfirstlane(tid >> 6), lane = tid & 63, wr = wid >> 2, wc = wid & 3, fr = lane & 15, fq = lane >> 4;
    const int K = g.K, nt = K / BK, lda = g.lda;
    unsigned voffA[2], voffB[2];
#pragma unroll
    for (int i = 0; i < 2; ++i) { int R, C; stage_rc(tid * 16 + i * 8192, R, C); const int Rb = Epi::PERM ? ((R & ~31) + perm32(R & 31)) : R;
        voffA[i] = (unsigned)(R * lda + C) * 2u; voffB[i] = (unsigned)(Rb * K + C) * 2u; }
    const size_t kstep = (size_t)(BK * 2);
    const size_t hstepA = (size_t)HALF * lda * 2, hstepB = (size_t)HALF * K * 2;
    const size_t tstepA = 2 * hstepA, tstepB = 2 * hstepB;
    const int ksplit = g.A2 ? g.ksplit : 0x7fffffff;
    const long dA = g.A2 ? ((const char*)g.A2 - (const char*)g.A) - (long)g.ksplit * (long)kstep : 0;
    const unsigned ldsw = (unsigned)wid * 1024u;
    const int aoff = lds_byte(wr * 64 + fr, fq * 8), boff = lds_byte(wc * 32 + fr, fq * 8);
    const int aoff8[2] = {aoff, aoff + 1024}, boff8[2] = {boff, boff + 1024};
#define PG8_SA(b, h) (((b) * 2 + (h)) * HTB)
#define PG8_SB(b, h) ((4 + (b) * 2 + (h)) * HTB)
#define PG8_STAGE(bufoff, gbase, voff) do { _Pragma("unroll") for (int _i = 0; _i < 2; ++_i) \
        __builtin_amdgcn_global_load_lds((const unsigned*)((const char*)(gbase) + (voff)[_i]), (LAS unsigned*)(lds + (bufoff) + ldsw + _i * 8192), 16, 0, 0); } while (0)
#define PG8_LDA(dst, b, h) do { if constexpr (FP8) { _Pragma("unroll") for (int m = 0; m < 4; ++m) { const i32x4 x0 = *(const LAS i32x4*)(lds + PG8_SA(b, h) + aoff8[0] + m * 2048), x1 = *(const LAS i32x4*)(lds + PG8_SA(b, h) + aoff8[1] + m * 2048); \
            dst##8[m] = (i32x8){x0[0], x0[1], x0[2], x0[3], x1[0], x1[1], x1[2], x1[3]}; } } \
        else { _Pragma("unroll") for (int m = 0; m < 4; ++m) _Pragma("unroll") for (int k = 0; k < 2; ++k) dst[m][k] = *(const LAS f16x8*)(lds + PG8_SA(b, h) + aoff + m * 2048 + k * 1024); } } while (0)
#define PG8_LDB(dst, b, h) do { if constexpr (FP8) { _Pragma("unroll") for (int n = 0; n < 2; ++n) { const i32x4 x0 = *(const LAS i32x4*)(lds + PG8_SB(b, h) + boff8[0] + n * 2048), x1 = *(const LAS i32x4*)(lds + PG8_SB(b, h) + boff8[1] + n * 2048); \
            dst##8[n] = (i32x8){x0[0], x0[1], x0[2], x0[3], x1[0], x1[1], x1[2], x1[3]}; } } \
        else { _Pragma("unroll") for (int n = 0; n < 2; ++n) _Pragma("unroll") for (int k = 0; k < 2; ++k) dst[n][k] = *(const LAS f16x8*)(lds + PG8_SB(b, h) + boff + n * 2048 + k * 1024); } } while (0)
#define PG8_MMA(ai, bj, At, Bt) do { __builtin_amdgcn_s_setprio(1); if constexpr (FP8) { _Pragma("unroll") for (int m = 0; m < 4; ++m) _Pragma("unroll") for (int n = 0; n < 2; ++n) \
            asm volatile("v_mfma_scale_f32_16x16x128_f8f6f4 %0, %1, %2, %0, %3, %3 op_sel_hi:[0,0,0]" : "+v"(acc[ai][bj][m][n]) : "v"(Bt##8[n]), "v"(At##8[m]), "v"(scale1)); } \
        else { _Pragma("unroll") for (int m = 0; m < 4; ++m) _Pragma("unroll") for (int n = 0; n < 2; ++n) _Pragma("unroll") for (int k = 0; k < 2; ++k) \
            acc[ai][bj][m][n] = __builtin_amdgcn_mfma_f32_16x16x32_f16(Bt[n][k], At[m][k], acc[ai][bj][m][n], 0, 0, 0); } __builtin_amdgcn_s_setprio(0); } while (0)
#define PG8_WAIT_V(n) asm volatile("s_waitcnt vmcnt(" #n ")" ::: "memory")
#define PG8_WAIT_L(n) asm volatile("s_waitcnt lgkmcnt(" #n ")" ::: "memory")
#define PG8_BAR __builtin_amdgcn_s_barrier()
#define PG8_SCHED __builtin_amdgcn_sched_barrier(0)
    Unit cur, nxt; int ui = 0;
    if (!S.next(0, cur)) return;
    f32x4 acc[2][2][4][2];
#pragma unroll
    for (int a = 0; a < 2; ++a)
#pragma unroll
        for (int b = 0; b < 2; ++b)
#pragma unroll
            for (int m = 0; m < 4; ++m)
#pragma unroll
                for (int n = 0; n < 2; ++n) acc[a][b][m][n] = (f32x4){0.f, 0.f, 0.f, 0.f};
    int scale1 = 0x7f7f7f7f; asm volatile("" : "+v"(scale1));
    f16x8 At[4][2], B0[2][2], B1[2][2]; i32x8 At8[4], B08[2], B18[2]; (void)At; (void)B0; (void)B1; (void)At8; (void)B08; (void)B18;
    const char* cA = (const char*)g.A + (size_t)cur.pm * tstepA; const char* cB = (const char*)g.Bt + (size_t)cur.pn * tstepB;
    PG8_STAGE(PG8_SB(0, 0), cB, voffB); PG8_STAGE(PG8_SB(0, 1), cB + hstepB, voffB); PG8_STAGE(PG8_SA(0, 0), cA, voffA); PG8_STAGE(PG8_SA(0, 1), cA + hstepA, voffA);
    if (wr == 1) PG8_BAR;
    PG8_WAIT_V(2); PG8_BAR;
    PG8_STAGE(PG8_SB(1, 0), cB + kstep, voffB); PG8_STAGE(PG8_SA(1, 0), cA + kstep, voffA); PG8_STAGE(PG8_SB(1, 1), cB + hstepB + kstep, voffB);
    PG8_WAIT_V(6); PG8_BAR;
    for (;;) {
        const bool has_next = S.next(ui + 1, nxt);
        const char* nA = has_next ? (const char*)g.A + (size_t)nxt.pm * tstepA : cA; const char* nB = has_next ? (const char*)g.Bt + (size_t)nxt.pn * tstepB : cB;
        for (int t = 0; t < nt; t += 2) {
            const bool last = (t == nt - 2);
            const char* a1 = cA + (size_t)(t + 1) * kstep + ((t + 1 >= ksplit) ? dA : 0);
            const char* a2 = last ? nA : cA + (size_t)(t + 2) * kstep + ((t + 2 >= ksplit) ? dA : 0); const char* b2 = last ? nB : cB + (size_t)(t + 2) * kstep;
            const char* a3 = last ? nA + kstep : cA + (size_t)(t + 3) * kstep + ((t + 3 >= ksplit) ? dA : 0); const char* b3 = b2 + kstep;
            if constexpr (Epi::HAS_MID) { if (t == ksplit) E.mid(acc, cur, wr, wc, fr, fq); }
            PG8_LDB(B0, 0, 0); PG8_LDB(B1, 0, 1); PG8_SCHED; PG8_LDA(At, 0, 0); PG8_STAGE(PG8_SA(1, 1), a1 + hstepA, voffA);
            PG8_WAIT_V(8); PG8_WAIT_L(0); PG8_BAR; PG8_MMA(0, 0, At, B0); PG8_MMA(0, 1, At, B1); PG8_BAR; PG8_SCHED;
            PG8_LDA(At, 0, 1); PG8_STAGE(PG8_SB(0, 0), b2, voffB); PG8_STAGE(PG8_SB(0, 1), b2 + hstepB, voffB); PG8_STAGE(PG8_SA(0, 0), a2, voffA);
            PG8_WAIT_V(8); PG8_WAIT_L(0); PG8_BAR; PG8_MMA(1, 0, At, B0); PG8_MMA(1, 1, At, B1); PG8_BAR; PG8_SCHED;
            PG8_LDB(B0, 1, 0); PG8_LDB(B1, 1, 1); PG8_SCHED; PG8_LDA(At, 1, 0); PG8_STAGE(PG8_SA(0, 1), a2 + hstepA, voffA);
            PG8_WAIT_V(8); PG8_WAIT_L(0); PG8_BAR; PG8_MMA(0, 0, At, B0); PG8_MMA(0, 1, At, B1); PG8_BAR; PG8_SCHED;
            PG8_LDA(At, 1, 1); PG8_STAGE(PG8_SB(1, 0), b3, voffB); PG8_STAGE(PG8_SB(1, 1), b3 + hstepB, voffB); PG8_STAGE(PG8_SA(1, 0), a3, voffA);
            PG8_WAIT_V(8); PG8_WAIT_L(0); PG8_BAR; PG8_MMA(1, 0, At, B0); PG8_MMA(1, 1, At, B1); PG8_BAR; PG8_SCHED;
        }
        if constexpr (ALIGN_EPI) { if (wr == 0) PG8_BAR; }
        if constexpr (FP8) asm volatile("s_nop 15\n\ts_nop 7" ::: "memory");
        E(acc, cur, wr, wc, fr, fq);
        if (!has_next) break;
#pragma unroll
        for (int a = 0; a < 2; ++a)
#pragma unroll
            for (int b = 0; b < 2; ++b)
#pragma unroll
                for (int m = 0; m < 4; ++m)
#pragma unroll
                    for (int n = 0; n < 2; ++n) acc[a][b][m][n] = (f32x4){0.f, 0.f, 0.f, 0.f};
        cur = nxt; cA = nA; cB = nB; ++ui;
        if constexpr (ALIGN_EPI) { if (wr == 1) PG8_BAR; }
    }
    PG8_WAIT_V(0);
    if constexpr (!ALIGN_EPI) { if (wr == 0) PG8_BAR; }
    PG8_BAR;
#undef PG8_SA
#undef PG8_SB
#undef PG8_STAGE
#undef PG8_LDA
#undef PG8_LDB
#undef PG8_MMA
#undef PG8_WAIT_V
#undef PG8_WAIT_L
#undef PG8_BAR
#undef PG8_SCHED
}

template <class Epi, bool ALIGN_EPI, bool FP8 = false>
__device__ __forceinline__ void gemm_phase(LAS unsigned char* lds, const Gemm g, const StaticOrder& S, const Epi& E) { gemm_phase_t<Epi, ALIGN_EPI, FP8, StaticOrder>(lds, g, S, E); }
__device__ __forceinline__ u32x4 pack8(const f32x4& v0, const f32x4& v1) { u32x4 w; w.x = pk2h(v0[0], v0[1]); w.y = pk2h(v0[2], v0[3]); w.z = pk2h(v1[0], v1[1]); w.w = pk2h(v1[2], v1[3]); return w; }
__device__ __forceinline__ f32x4 sig4(const f32x4& v) { return (f32x4){sigmoidf_(v[0]), sigmoidf_(v[1]), sigmoidf_(v[2]), sigmoidf_(v[3])}; }
__device__ __forceinline__ void unpack8(const u32x4& w, f32x4& a, f32x4& b) {
    const f16x8 h = __builtin_bit_cast(f16x8, w);
    a = (f32x4){(float)h[0], (float)h[1], (float)h[2], (float)h[3]}; b = (f32x4){(float)h[4], (float)h[5], (float)h[6], (float)h[7]};
}
struct EpiProj {
    static constexpr bool PERM = true, HAS_MID = false;
    f16 *qkva, *qi, *kiw, *wi, *qkvb;
    __device__ __forceinline__ void operator()(const f32x4 (&acc)[2][2][4][2], const Unit& u, int wr, int wc, int fr, int fq) const {
        const int pn = u.pn; f16* base; int ldc, colt, limit = 256;
        if (pn < 6) { base = qkva; ldc = P_QKV; colt = pn * 256; }
        else if (pn < 8) { base = qi; ldc = 512; colt = (pn - 6) * 256; }
        else if (pn == 8) { base = kiw; ldc = P_KI; colt = 0; limit = 64; }
        else { base = qkvb; ldc = P_QKV; colt = (pn - 9) * 256; }
        const int row0 = u.pm * BM + wr * 64 + fr, cw = wc * 32 + 8 * fq;
#pragma unroll
        for (int ai = 0; ai < 2; ++ai)
#pragma unroll
            for (int m = 0; m < 4; ++m) { f16* rowp = base + (size_t)(row0 + ai * HALF + m * 16) * ldc + colt + cw;
                {
#pragma unroll
                for (int bj = 0; bj < 2; ++bj) if (bj * HALF + cw < limit) { f32x4 v0 = acc[ai][bj][m][0], v1 = acc[ai][bj][m][1];
                    *(u32x4*)(rowp + bj * HALF) = pack8(v0, v1); } }
                if (pn == 8 && cw == 64) *(u32x4*)(wi + (size_t)(row0 + ai * HALF + m * 16) * 8) = pack8(acc[ai][0][m][0], acc[ai][0][m][1]); }
    }
};
template <int MODE> struct EpiGate {
    static constexpr bool PERM = true, HAS_MID = false;
    f16* mo; const f16* gates;
    __device__ __forceinline__ void operator()(const f32x4 (&acc)[2][2][4][2], const Unit& u, int wr, int wc, int fr, int fq) const {
        const int row0 = u.pm * BM + wr * 64 + fr, col0 = u.pn * BM + wc * 32 + 8 * fq;
#pragma unroll
        for (int ai = 0; ai < 2; ++ai)
#pragma unroll
            for (int m = 0; m < 4; ++m) { const size_t row = (size_t)(row0 + ai * HALF + m * 16);
#pragma unroll
                for (int bj = 0; bj < 2; ++bj) { const int col = col0 + bj * HALF;
                    f32x4 g0, g1; unpack8(*(const u32x4*)(gates + row * 2048 + MODE * 1024 + col), g0, g1);
                    f32x4 v0 = acc[ai][bj][m][0] * g0, v1 = acc[ai][bj][m][1] * g1;
                    f16* op = mo + row * DM + col;
                    if (MODE == 1) { f32x4 p0, p1; unpack8(*(const u32x4*)op, p0, p1); v0 += p0; v1 += p1; }
                    *(u32x4*)op = pack8(v0, v1); } }
    }
};
constexpr float H8_SCALE = 16.0f, WG_SCALE = 64.0f;
struct EpiGates8 {
    static constexpr bool PERM = true, HAS_MID = false;
    f16* gates;
    __device__ __forceinline__ void operator()(const f32x4 (&acc)[2][2][4][2], const Unit& u, int wr, int wc, int fr, int fq) const {
        const int row0 = u.pm * BM + wr * 64 + fr, cw = wc * 32 + 8 * fq; constexpr float s = 1.0f / (H8_SCALE * WG_SCALE);
#pragma unroll
        for (int ai = 0; ai < 2; ++ai)
#pragma unroll
            for (int m = 0; m < 4; ++m) { f16* rowp = gates + (size_t)(row0 + ai * HALF + m * 16) * 2048 + u.pn * 128 + cw;
                f32x4 a0 = sig4(acc[ai][0][m][0] * s), a1 = sig4(acc[ai][0][m][1] * s), b0 = sig4(acc[ai][1][m][0] * s), b1 = sig4(acc[ai][1][m][1] * s);
#pragma unroll
                for (int e = 0; e < 4; ++e) { b0[e] = fmaxf(b0[e], 6.103515625e-5f); b1[e] = fmaxf(b1[e], 6.103515625e-5f); a0[e] *= __builtin_amdgcn_rcpf(b0[e]); a1[e] *= __builtin_amdgcn_rcpf(b1[e]); }
                *(u32x4*)rowp = pack8(a0, a1); *(u32x4*)(rowp + 1024) = pack8(b0, b1); }
    }
};
struct EpiGateMerged {
    static constexpr bool PERM = true, HAS_MID = true;
    f16* mo; const f16* gates;
    __device__ __forceinline__ void mid(f32x4 (&acc)[2][2][4][2], const Unit& u, int wr, int wc, int fr, int fq) const {
        asm volatile("" : "+v"(fr));
        const int row0 = u.pm * BM + wr * 64 + fr, col0 = u.pn * BM + wc * 32 + 8 * fq;
#pragma unroll
        for (int ai = 0; ai < 2; ++ai) {
#pragma unroll
            for (int m = 0; m < 4; ++m) { const size_t row = (size_t)(row0 + ai * HALF + m * 16);
#pragma unroll
                for (int bj = 0; bj < 2; ++bj) { f32x4 r0, r1; unpack8(*(const u32x4*)(gates + row * 2048 + col0 + bj * HALF), r0, r1); acc[ai][bj][m][0] *= r0; acc[ai][bj][m][1] *= r1; }
                if (m & 1) asm volatile("" ::: "memory"); } }
    }
    __device__ __forceinline__ void operator()(const f32x4 (&acc)[2][2][4][2], const Unit& u, int wr, int wc, int fr, int fq) const {
        const int row0 = u.pm * BM + wr * 64 + fr, col0 = u.pn * BM + wc * 32 + 8 * fq;
#pragma unroll
        for (int ai = 0; ai < 2; ++ai)
#pragma unroll
            for (int m = 0; m < 4; ++m) { const size_t row = (size_t)(row0 + ai * HALF + m * 16);
#pragma unroll
                for (int bj = 0; bj < 2; ++bj) { const int col = col0 + bj * HALF;
                    f32x4 b0, b1; unpack8(*(const u32x4*)(gates + row * 2048 + 1024 + col), b0, b1);
                    *(u32x4*)(mo + row * DM + col) = pack8(acc[ai][bj][m][0] * b0, acc[ai][bj][m][1] * b1); }
                if (m & 1) asm volatile("" ::: "memory"); }
    }
};
struct EpiF32 {
    static constexpr bool PERM = false, HAS_MID = false;
    float* C; int ldc;
    __device__ __forceinline__ void operator()(const f32x4 (&acc)[2][2][4][2], const Unit& u, int wr, int wc, int fr, int fq) const {
        const int row0 = u.pm * BM + wr * 64 + fr, col0 = u.pn * BM + wc * 32 + 4 * fq;
#pragma unroll
        for (int ai = 0; ai < 2; ++ai)
#pragma unroll
            for (int m = 0; m < 4; ++m) { float* rowp = C + (size_t)(row0 + ai * HALF + m * 16) * ldc + col0;
#pragma unroll
                for (int bj = 0; bj < 2; ++bj)
#pragma unroll
                    for (int n = 0; n < 2; ++n) *(f32x4*)(rowp + bj * HALF + n * 16) = acc[ai][bj][m][n]; }
    }
};
struct EpiF16 {
    static constexpr bool PERM = true, HAS_MID = false;
    f16* C; int ldc;
    __device__ __forceinline__ void operator()(const f32x4 (&acc)[2][2][4][2], const Unit& u, int wr, int wc, int fr, int fq) const {
        const int row0 = u.pm * BM + wr * 64 + fr, col0 = u.pn * BM + wc * 32 + 8 * fq;
#pragma unroll
        for (int ai = 0; ai < 2; ++ai)
#pragma unroll
            for (int m = 0; m < 4; ++m) { f16* rowp = C + (size_t)(row0 + ai * HALF + m * 16) * ldc + col0;
#pragma unroll
                for (int bj = 0; bj < 2; ++bj) *(u32x4*)(rowp + bj * HALF) = pack8(acc[ai][bj][m][0], acc[ai][bj][m][1]); }
    }
};
struct EpiSwiglu {
    static constexpr bool PERM = true, HAS_MID = false;
    f16* hid;
    __device__ __forceinline__ void operator()(const f32x4 (&acc)[2][2][4][2], const Unit& u, int wr, int wc, int fr, int fq) const {
        const int row0 = u.pm * BM + wr * 64 + fr, col0 = u.pn * HALF + wc * 32 + 8 * fq;
#pragma unroll
        for (int ai = 0; ai < 2; ++ai)
#pragma unroll
            for (int m = 0; m < 4; ++m) { f32x4 h[2];
#pragma unroll
                for (int n = 0; n < 2; ++n) { const f32x4 gg = acc[ai][0][m][n], uu = acc[ai][1][m][n]; h[n] = gg * sig4(gg) * uu; }
                *(u32x4*)(hid + (size_t)(row0 + ai * HALF + m * 16) * DFF + col0) = pack8(h[0], h[1]); }
    }
};
constexpr float HID_SCALE = 8.0f, WD_SCALE = 64.0f;
struct EpiSwiglu8 {
    static constexpr bool PERM = true, HAS_MID = false;
    unsigned char* hid8;
    __device__ __forceinline__ void operator()(const f32x4 (&acc)[2][2][4][2], const Unit& u, int wr, int wc, int fr, int fq) const {
        const int row0 = u.pm * BM + wr * 64 + fr, col0 = u.pn * HALF + wc * 32 + 8 * fq;
#pragma unroll
        for (int ai = 0; ai < 2; ++ai)
#pragma unroll
            for (int m = 0; m < 4; ++m) { f32x4 h[2];
#pragma unroll
                for (int n = 0; n < 2; ++n) { const f32x4 gg = acc[ai][0][m][n], uu = acc[ai][1][m][n]; h[n] = gg * sig4(gg) * uu * HID_SCALE;
#pragma unroll
                    for (int e = 0; e < 4; ++e) h[n][e] = __builtin_amdgcn_fmed3f(h[n][e], -448.f, 448.f); }
                int w0 = 0, w1 = 0;
                w0 = __builtin_amdgcn_cvt_pk_fp8_f32(h[0][0], h[0][1], w0, false); w0 = __builtin_amdgcn_cvt_pk_fp8_f32(h[0][2], h[0][3], w0, true);
                w1 = __builtin_amdgcn_cvt_pk_fp8_f32(h[1][0], h[1][1], w1, false); w1 = __builtin_amdgcn_cvt_pk_fp8_f32(h[1][2], h[1][3], w1, true);
                *(u32x2*)(hid8 + (size_t)(row0 + ai * HALF + m * 16) * DFF + col0) = (u32x2){(unsigned)w0, (unsigned)w1}; }
    }
};
struct EpiF16S {
    static constexpr bool PERM = true, HAS_MID = false;
    f16* C; int ldc; float s;
    __device__ __forceinline__ void operator()(const f32x4 (&acc)[2][2][4][2], const Unit& u, int wr, int wc, int fr, int fq) const {
        const int row0 = u.pm * BM + wr * 64 + fr, col0 = u.pn * BM + wc * 32 + 8 * fq;
#pragma unroll
        for (int ai = 0; ai < 2; ++ai)
#pragma unroll
            for (int m = 0; m < 4; ++m) { f16* rowp = C + (size_t)(row0 + ai * HALF + m * 16) * ldc + col0;
#pragma unroll
                for (int bj = 0; bj < 2; ++bj) *(u32x4*)(rowp + bj * HALF) = pack8(acc[ai][bj][m][0] * s, acc[ai][bj][m][1] * s); }
    }
};
}
struct Frame {
    LAS unsigned char* lds;
    volatile LAS unsigned* MISC;
    unsigned* ctl;
    int tid, lane, wave, vcu, G;
};

enum { MAT_IN = 0, MAT_A, MAT_B, MAT_O, MAT_GU, MAT_D, MAT_G8 };
__device__ __forceinline__ int src_col(int mat, int n, float& scale) {
    scale = 1.f;
    if (mat == MAT_IN) {
        if (n < 1536) { if (n < 512) scale = C2A; return n; }
        if (n < 2048) return n;
        if (n < 2304) { const int j = n - 2048; return j < 72 ? 2048 + j : -1; }
        if (n < 3840) { const int j = n - 2304; if (j < 512) scale = C2B; return 2120 + j; }
        { const int j = n - 3840, pg = j >> 8, jj = j & 255; return (jj < 128 ? 3656 : 4680) + pg * 128 + (jj & 127); }
    }
    if (mat == MAT_G8) { const int pg = n >> 8, jj = n & 255; return (jj < 128 ? 3656 : 4680) + pg * 128 + (jj & 127); }
    if (mat == MAT_GU) { const int pn = n >> 8, j = n & 255; return (j < 128 ? 0 : DFF) + pn * 128 + (j & 127); }
    return n;
}
__device__ __forceinline__ void transpose_item(const float* W, int K, int Nsrc, int nblk, int mat, f16* WT, LAS float* scr, int item, int lane) {
    const int kb = item / nblk, nb = item % nblk, k0 = 64 * kb, n0 = 64 * nb;
    const int n4 = (lane & 15) * 4; float scale; const int sc = src_col(mat, n0 + n4, scale);
    const float* src = W + (size_t)(k0 + (lane >> 4)) * Nsrc + (sc >= 0 ? sc : 0);
    f32x4 v[16];
#pragma unroll
    for (int i = 0; i < 16; ++i) v[i] = sc >= 0 ? *(const f32x4*)(src + (size_t)(4 * i) * Nsrc) : (f32x4){0.f, 0.f, 0.f, 0.f};
#pragma unroll
    for (int i = 0; i < 16; ++i) *(LAS f32x4*)(scr + ((lane >> 4) + 4 * i) * 68 + n4) = v[i] * scale;
    LDS_WAIT(); asm volatile("" ::: "memory");
    const int c = lane & 7;
#pragma unroll
    for (int j = 0; j < 8; ++j) { const int n = (lane >> 3) + 8 * j; const LAS float* s = scr + (8 * c) * 68 + n;
        u32x4 o; o.x = pk2h(s[0 * 68], s[1 * 68]); o.y = pk2h(s[2 * 68], s[3 * 68]); o.z = pk2h(s[4 * 68], s[5 * 68]); o.w = pk2h(s[6 * 68], s[7 * 68]);
        *(u32x4*)(WT + (size_t)(n0 + n) * K + k0 + 8 * c) = o; }
    LDS_WAIT(); asm volatile("" ::: "memory");
}
__device__ __forceinline__ void transpose_item_fp8(const float* W, int K, int Nsrc, int nblk, int mat, float wscale, f16* WT_, LAS float* scr, int item, int lane) {
    unsigned char* WT = (unsigned char*)WT_;
    const int kb = item / nblk, nb = item % nblk, k0 = 64 * kb, n0 = 64 * nb;
    const int n4 = (lane & 15) * 4; float sc_; const int sc = src_col(mat, n0 + n4, sc_);
    const float* src = W + (size_t)(k0 + (lane >> 4)) * Nsrc + sc;
    f32x4 v[16];
#pragma unroll
    for (int i = 0; i < 16; ++i) v[i] = *(const f32x4*)(src + (size_t)(4 * i) * Nsrc);
#pragma unroll
    for (int i = 0; i < 16; ++i) *(LAS f32x4*)(scr + ((lane >> 4) + 4 * i) * 68 + n4) = v[i] * wscale;
    LDS_WAIT(); asm volatile("" ::: "memory");
    const int c = lane & 7;
#pragma unroll
    for (int j = 0; j < 8; ++j) { const int n = (lane >> 3) + 8 * j; const LAS float* s = scr + (8 * c) * 68 + n;
        int w0 = 0, w1 = 0;
        w0 = __builtin_amdgcn_cvt_pk_fp8_f32(s[0 * 68], s[1 * 68], w0, false); w0 = __builtin_amdgcn_cvt_pk_fp8_f32(s[2 * 68], s[3 * 68], w0, true);
        w1 = __builtin_amdgcn_cvt_pk_fp8_f32(s[4 * 68], s[5 * 68], w1, false); w1 = __builtin_amdgcn_cvt_pk_fp8_f32(s[6 * 68], s[7 * 68], w1, true);
        *(u32x2*)(WT + (size_t)(n0 + n) * K + k0 + 8 * c) = (u32x2){(unsigned)w0, (unsigned)w1}; }
    LDS_WAIT(); asm volatile("" ::: "memory");
}
struct Inputs { const float *x, *w_in, *w_a, *w_b, *w_o, *w_gu, *w_d, *g_pre_mix, *g_post_mix, *g_pre_ffn, *g_post_ffn, *rel_bias; };

__device__ __forceinline__ void convert_weights(Frame& F0, const Inputs& I, unsigned char* ws, int l) {
    Frame F = F0; asm volatile("" : "+v"(F.lane));
    LAS float* scr = (LAS float*)(F.lds + F.wave * 17408);
    const int gw = F.vcu * 8 + F.wave, NGW = F.G * 8;
    constexpr int I_IN = (DM / 64) * (NIN16 / 64), I_G8 = (DM / 64) * (2048 / 64), I_A = (512 / 64) * (DM / 64), I_O = (DM / 64) * (DM / 64), I_GU = (DM / 64) * (NGU / 64), I_D = (DFF / 64) * (DM / 64);
    constexpr int PER_LAYER = I_IN + I_G8 + 2 * I_A + I_O + I_GU + I_D;
    unsigned char* wt = ws + WS_WT;
    for (int it = gw; it < PER_LAYER; it += NGW) {
        int r = it;
        if (r < I_IN) { transpose_item(I.w_in + (size_t)l * DM * NIN_SRC, DM, NIN_SRC, NIN16 / 64, MAT_IN, (f16*)(wt + WT_IN), scr, r, F.lane); continue; } r -= I_IN;
        if (r < I_G8) { transpose_item_fp8(I.w_in + (size_t)l * DM * NIN_SRC, DM, NIN_SRC, 2048 / 64, MAT_G8, pg8::WG_SCALE, (f16*)(wt + WT_G8), scr, r, F.lane); continue; } r -= I_G8;
        if (r < I_A) { transpose_item(I.w_a + (size_t)l * 512 * DM, DM, DM, DM / 64, MAT_A, (f16*)(wt + WT_A), scr, r, F.lane); continue; } r -= I_A;
        if (r < I_A) { transpose_item(I.w_b + (size_t)l * 512 * DM, DM, DM, DM / 64, MAT_B, (f16*)(wt + WT_A) + 512, scr, r, F.lane); continue; } r -= I_A;
        if (r < I_O) { transpose_item(I.w_o + (size_t)l * DM * DM, DM, DM, DM / 64, MAT_O, (f16*)(wt + WT_O), scr, r, F.lane); continue; } r -= I_O;
        if (r < I_GU) { transpose_item(I.w_gu + (size_t)l * DM * NGU, DM, NGU, NGU / 64, MAT_GU, (f16*)(wt + WT_GU), scr, r, F.lane); continue; } r -= I_GU;
        transpose_item_fp8(I.w_d + (size_t)l * DFF * DM, DFF, DM, DM / 64, MAT_D, pg8::WD_SCALE, (f16*)(wt + WT_D), scr, r, F.lane);
    }
}

__device__ __forceinline__ float sat8(float v) { return __builtin_amdgcn_fmed3f(v, -448.f, 448.f); }
__device__ __forceinline__ unsigned pk4f8(const f32x4& t, float s) { int w = 0; w = __builtin_amdgcn_cvt_pk_fp8_f32(sat8(t.x * s), sat8(t.y * s), w, false); w = __builtin_amdgcn_cvt_pk_fp8_f32(sat8(t.z * s), sat8(t.w * s), w, true); return (unsigned)w; }
__device__ __forceinline__ void norm_to_f16(Frame& F0, const float* x, const float* g, f16* h, unsigned char* h8) {
    Frame F = F0; asm volatile("" : "+v"(F.lane));
    const int gw = F.vcu * 8 + F.wave, NGW = F.G * 8;
    f32x4 gv[4];
#pragma unroll
    for (int j = 0; j < 4; ++j) gv[j] = ((const f32x4*)g)[F.lane + 64 * j];
    f32x4 ra[4], rb[4];
#pragma unroll
    for (int j = 0; j < 4; ++j) ra[j] = ((const GAS f32x4*)(x + (size_t)gw * DM) + F.lane)[64 * j];
#pragma unroll
    for (int j = 0; j < 4; ++j) rb[j] = ((const GAS f32x4*)(x + (size_t)(gw + NGW) * DM) + F.lane)[64 * j];
    __builtin_amdgcn_s_waitcnt(0x0F70);
    auto row = [&](int m, f32x4 (&r)[4]) {
        f32x4 v[4]; float s = 0.f;
#pragma unroll
        for (int j = 0; j < 4; ++j) v[j] = r[j];
        { const int mn = (m + 2 * NGW < M) ? m + 2 * NGW : m; const GAS f32x4* xr = (const GAS f32x4*)(x + (size_t)mn * DM) + F.lane;
#pragma unroll
          for (int j = 0; j < 4; ++j) r[j] = xr[64 * j]; }
        asm volatile("" ::: "memory");
#pragma unroll
        for (int j = 0; j < 4; ++j) s += (v[j].x * v[j].x + v[j].y * v[j].y) + (v[j].z * v[j].z + v[j].w * v[j].w);
        const float rstd = 1.0f / sqrtf(wave_sum(s) * (1.f / DM) + RMS_EPS);
        GAS u32x2* o = (GAS u32x2*)(h + (size_t)m * DM) + F.lane;
#pragma unroll
        for (int j = 0; j < 4; ++j) { const f32x4 t = v[j] * rstd * gv[j]; o[64 * j] = (u32x2){pk2h(t.x, t.y), pk2h(t.z, t.w)}; ((GAS unsigned*)(h8 + (size_t)m * DM))[F.lane + 64 * j] = pk4f8(t, pg8::H8_SCALE); }
    };
    for (int m = gw; m < M; m += 2 * NGW) { row(m, ra); row(m + NGW, rb); }
}
template <bool XI16> struct XRaw;
template <> struct XRaw<true> { f16x4 r[4]; __device__ __forceinline__ void load(const void* p, size_t m, int lane) { _Pragma("unroll") for (int j = 0; j < 4; ++j) r[j] = ((const GAS f16x4*)((const f16*)p + m * DM) + lane)[64 * j]; }
    __device__ __forceinline__ f32x4 get(int j) const { return (f32x4){(float)r[j][0], (float)r[j][1], (float)r[j][2], (float)r[j][3]}; } };
template <> struct XRaw<false> { f32x4 r[4]; __device__ __forceinline__ void load(const void* p, size_t m, int lane) { _Pragma("unroll") for (int j = 0; j < 4; ++j) r[j] = ((const GAS f32x4*)((const float*)p + m * DM) + lane)[64 * j]; }
    __device__ __forceinline__ f32x4 get(int j) const { return r[j]; } };
template <bool XI16, bool XO16> __device__ __forceinline__ void norm_residual(Frame& F0, const void* xi_, const f16* y, const float* g1, void* xo_, const float* g2, f16* h, unsigned char* h8) {
    Frame F = F0; asm volatile("" : "+v"(F.lane));
    const int gw = F.vcu * 8 + F.wave, NGW = F.G * 8;
    f32x4 gv1[4], gv2[4];
#pragma unroll
    for (int j = 0; j < 4; ++j) { gv1[j] = ((const f32x4*)g1)[F.lane + 64 * j]; gv2[j] = h ? ((const f32x4*)g2)[F.lane + 64 * j] : (f32x4){0.f, 0.f, 0.f, 0.f}; }
    XRaw<true> ya, yb; XRaw<XI16> xa, xb;
    ya.load(y, (size_t)gw, F.lane); xa.load(xi_, (size_t)gw, F.lane); yb.load(y, (size_t)(gw + NGW), F.lane); xb.load(xi_, (size_t)(gw + NGW), F.lane);
    __builtin_amdgcn_s_waitcnt(0x0F70);
    auto row = [&](int m, XRaw<true>& ry, XRaw<XI16>& rx) {
        f32x4 v[4], xv[4]; float s = 0.f;
#pragma unroll
        for (int j = 0; j < 4; ++j) { v[j] = ry.get(j); xv[j] = rx.get(j); }
        { const int mn = (m + 2 * NGW < M) ? m + 2 * NGW : m; ry.load(y, (size_t)mn, F.lane); rx.load(xi_, (size_t)mn, F.lane); }
        asm volatile("" ::: "memory");
#pragma unroll
        for (int j = 0; j < 4; ++j) s += (v[j].x * v[j].x + v[j].y * v[j].y) + (v[j].z * v[j].z + v[j].w * v[j].w);
        const float rstd = 1.0f / sqrtf(wave_sum(s) * (1.f / DM) + RMS_EPS);
        float s2 = 0.f;
#pragma unroll
        for (int j = 0; j < 4; ++j) { xv[j] = xv[j] + v[j] * rstd * gv1[j];
            if (XO16) ((GAS u32x2*)((f16*)xo_ + (size_t)m * DM) + F.lane)[64 * j] = (u32x2){pk2h(xv[j].x, xv[j].y), pk2h(xv[j].z, xv[j].w)};
            else ((GAS f32x4*)((float*)xo_ + (size_t)m * DM) + F.lane)[64 * j] = xv[j];
            s2 += (xv[j].x * xv[j].x + xv[j].y * xv[j].y) + (xv[j].z * xv[j].z + xv[j].w * xv[j].w); }
        if (h) {
            const float rstd2 = 1.0f / sqrtf(wave_sum(s2) * (1.f / DM) + RMS_EPS);
            GAS u32x2* o = (GAS u32x2*)(h + (size_t)m * DM) + F.lane;
#pragma unroll
            for (int j = 0; j < 4; ++j) { const f32x4 t = xv[j] * rstd2 * gv2[j]; o[64 * j] = (u32x2){pk2h(t.x, t.y), pk2h(t.z, t.w)}; if (h8) ((GAS unsigned*)(h8 + (size_t)m * DM))[F.lane + 64 * j] = pk4f8(t, pg8::H8_SCALE); }
        }
    };
    for (int m = gw; m < M; m += 2 * NGW) { row(m, ya, xa); row(m + NGW, yb, xb); }
}
#define MFMA32(a, b, c) __builtin_amdgcn_mfma_f32_32x32x16_f16(a, b, c, 0, 0, 0)
#define WAIT_BAR0() asm volatile("s_waitcnt vmcnt(0) lgkmcnt(0)\n\ts_barrier" ::: "memory")
typedef LAS const unsigned char* lds_cptr;
__device__ __forceinline__ int crow(int r, int hi) { return (r & 3) + 8 * (r >> 2) + 4 * hi; }
__device__ __forceinline__ void glds16(const void* g, unsigned lds_base) {
    unsigned sv; asm volatile("s_mov_b32 %0, m0\n\ts_mov_b32 m0, %2\n\ts_nop 0\n\tglobal_load_lds_dwordx4 %1, off\n\ts_mov_b32 m0, %0" : "=&s"(sv) : "v"(g), "s"(lds_base) : "memory"); }
__device__ __forceinline__ void glds16s(unsigned voff, const void* sbase, unsigned lds_base) {
    unsigned sv; asm volatile("s_mov_b32 %0, m0\n\ts_mov_b32 m0, %3\n\ts_nop 0\n\tglobal_load_lds_dwordx4 %1, %2\n\ts_mov_b32 m0, %0" : "=&s"(sv) : "v"(voff), "s"(sbase), "s"(lds_base) : "memory"); }
__device__ __forceinline__ s16x4 vtr(lds_cptr p) { return __builtin_bit_cast(s16x4, __builtin_amdgcn_ds_read_tr16_b64_v4i16((LAS v4i16_t*)p)); }
__device__ __forceinline__ float rowmax32(const f32x16& p0, const f32x16& p1) {
    float a = fmaxf(fmaxf(p0[0], p0[1]), p1[0]), b = fmaxf(fmaxf(p0[2], p0[3]), p1[1]); a = fmaxf(fmaxf(a, p1[2]), p1[3]);
#pragma unroll
    for (int r = 4; r < 16; r += 4) { a = fmaxf(fmaxf(a, p0[r]), p0[r + 1]); b = fmaxf(fmaxf(b, p0[r + 2]), p0[r + 3]); a = fmaxf(fmaxf(a, p1[r]), p1[r + 1]); b = fmaxf(fmaxf(b, p1[r + 2]), p1[r + 3]); }
    const float m = fmaxf(a, b); auto rr = __builtin_amdgcn_permlane32_swap(__float_as_uint(m), __float_as_uint(m), false, false);
    return fmaxf(__uint_as_float(rr[0]), __uint_as_float(rr[1]));
}
__device__ __forceinline__ void qk_tile(f32x16& p0, f32x16& p1, lds_cptr kp, const f16x8 (&qr)[4]) {
    p0 = f32x16{}; p1 = f32x16{};
#pragma unroll
    for (int d0 = 0; d0 < 4; ++d0) { const f16x8 k0 = *(const LAS f16x8*)(kp + d0 * 2048), k1 = *(const LAS f16x8*)(kp + d0 * 2048 + 512);
        p0 = MFMA32(k0, qr[d0], p0); p1 = MFMA32(k1, qr[d0], p1); }
}
__device__ __forceinline__ void pv_tile(f32x16 (&o)[2], lds_cptr vp, const u32x4 (&pw)[4]) {
#pragma unroll
    for (int dh = 0; dh < 2; ++dh)
#pragma unroll
        for (int ks = 0; ks < 4; ++ks) { const s16x4 lo = vtr(vp + dh * 4096 + ks * 1024), hi = vtr(vp + dh * 4096 + ks * 1024 + 512);
            const s16x4 z[2] = {lo, hi}; const f16x8 vf = __builtin_bit_cast(f16x8, z);
            o[dh] = MFMA32(__builtin_bit_cast(f16x8, pw[ks]), vf, o[dh]); }
}
__device__ __forceinline__ void store_o(const f32x16 (&o)[2], const float (&rs)[16], LAS f16* stg, f16* Ow, int pitch, int lane) {
    const int r32 = lane & 31, hi = lane >> 5;
#pragma unroll
    for (int r = 0; r < 16; ++r) { const int orow = crow(r, hi);
#pragma unroll
        for (int d0 = 0; d0 < 2; ++d0) stg[orow * 64 + d0 * 32 + r32] = (f16)(o[d0][r] * rs[r]); }
    LDS_WAIT(); asm volatile("" ::: "memory");
#pragma unroll
    for (int i = 0; i < 4; ++i) { const int row = i * 8 + (lane >> 3), ch = lane & 7; *(u32x4*)(Ow + (size_t)row * pitch + ch * 8) = *(const LAS u32x4*)(stg + row * 64 + ch * 8); }
}
constexpr int AT_LK = 0, AT_LV = 16384, AT_LTB = 32768, AT_LWS = 33792, AT_LOST = 35840, AT_LDS = AT_LOST + 8 * 4096;

__device__ __forceinline__ void sbattn_unit(int b, int h, int qb, const f16* QKV, f16* Odst, int opitch, LAS unsigned char* shm) {
    int tid = threadIdx.x; asm volatile("" : "+v"(tid)); const int lane = tid & 63, r32 = lane & 31, hi = lane >> 5; const int wid = __builtin_amdgcn_readfirstlane(tid >> 6);
    const size_t rowbase = (size_t)b * SEQ; const int Q0 = qb * 256, w0 = Q0 + wid * 32, jmax = 4 * qb + 3;
    const f16* Qw = QKV + (rowbase + w0) * P_QKV + h * 64;
    const f16* ksrc = QKV + (rowbase + lane) * P_QKV + 512 + h * 64 + wid * 8;
    const f16* vsrc = QKV + (rowbase + 16 * (wid & 3) + (lane >> 2)) * P_QKV + 1024 + h * 64 + (wid >> 2) * 32 + (lane & 3) * 8;
    const unsigned lds0 = (unsigned)(uintptr_t)shm;
    const unsigned kdst = lds0 + AT_LK + wid * 1024, vdst = lds0 + AT_LV + wid * 1024;
#define SB_DMA(t, slot) do { glds16(ksrc + (size_t)(t) * 64 * P_QKV, (unsigned)__builtin_amdgcn_readfirstlane(kdst + (slot) * 8192)); \
                             glds16(vsrc + (size_t)(t) * 64 * P_QKV, (unsigned)__builtin_amdgcn_readfirstlane(vdst + (slot) * 8192)); } while (0)
    LAS unsigned* flags = (LAS unsigned*)(shm + AT_LWS);
    SB_DMA(jmax, 0);
    f16x8 qr[4];
#pragma unroll
    for (int d0 = 0; d0 < 4; ++d0) qr[d0] = *(const f16x8*)(Qw + (size_t)r32 * P_QKV + d0 * 16 + hi * 8);
    float carry = 1.0f; f32x16 o[2]; o[0] = f32x16{}; o[1] = f32x16{};
    const lds_cptr kp0 = (lds_cptr)shm + AT_LK + hi * 1024 + r32 * 16;
    const lds_cptr vp0 = (lds_cptr)shm + AT_LV + ((lane >> 4) & 1) * 32 + (lane & 3) * 8 + (4 * hi + ((lane & 15) >> 2)) * 64;
    WAIT_BAR0();
    int it = 0; bool live = true;
    for (int t = jmax; t >= 0; --t, ++it) {
        const int slot = it & 1;
        if (t > 0) SB_DMA(t - 1, slot ^ 1);
        if (64 * t < w0 + 31 && live) {
            f32x16 k0, k1; qk_tile(k0, k1, kp0 + slot * 8192, qr);
            f32x16 b0, b1;
            const bool band = (64 * t + 63 >= w0); const int kb0 = 64 * t + 4 * hi - (w0 + r32);
#pragma unroll
            for (int r = 0; r < 16; ++r) { const int kc = (r & 3) + 8 * (r >> 2);
                const float E0 = __builtin_amdgcn_exp2f(k0[r]), E1 = __builtin_amdgcn_exp2f(k1[r]);
                float kk0 = __builtin_amdgcn_rcpf(1.0f + E0), kk1 = __builtin_amdgcn_rcpf(1.0f + E1); float bb0 = 1.0f - kk0, bb1 = 1.0f - kk1;
                if (band) { if (kb0 + kc >= 0) { kk0 = 1.f; bb0 = 0.f; } if (kb0 + kc + 32 >= 0) { kk1 = 1.f; bb1 = 0.f; } }
                k0[r] = kk0; k1[r] = kk1; b0[r] = bb0; b1[r] = bb1; }
            float gp[8];
#pragma unroll
            for (int j = 0; j < 4; ++j) {
                { const float s2 = k0[4 * j + 3], s1 = s2 * k0[4 * j + 2], s0 = s1 * k0[4 * j + 1]; gp[j] = s0 * k0[4 * j]; b0[4 * j + 2] *= s2; b0[4 * j + 1] *= s1; b0[4 * j] *= s0; }
                { const float s2 = k1[4 * j + 3], s1 = s2 * k1[4 * j + 2], s0 = s1 * k1[4 * j + 1]; gp[4 + j] = s0 * k1[4 * j]; b1[4 * j + 2] *= s2; b1[4 * j + 1] *= s1; b1[4 * j] *= s0; }
            }
            float base[8]; float sp = carry;
#pragma unroll
            for (int g = 7; g >= 0; --g) { const unsigned own = __float_as_uint(gp[g]); auto rr = __builtin_amdgcn_permlane32_swap(own, own, false, false);
                base[g] = sp * (hi ? 1.0f : __uint_as_float(rr[1])); sp *= __uint_as_float(rr[0]) * __uint_as_float(rr[1]); }
            carry = sp;
#pragma unroll
            for (int j = 0; j < 4; ++j)
#pragma unroll
                for (int i = 0; i < 4; ++i) { b0[4 * j + i] *= base[j]; b1[4 * j + i] *= base[4 + j]; }
            u32x4 pw[4];
#pragma unroll
            for (int k = 0; k < 4; ++k) { pw[0][k] = pk2h(b0[2 * k], b0[2 * k + 1]); pw[1][k] = pk2h(b0[8 + 2 * k], b0[9 + 2 * k]); pw[2][k] = pk2h(b1[2 * k], b1[2 * k + 1]); pw[3][k] = pk2h(b1[8 + 2 * k], b1[9 + 2 * k]); }
            pv_tile(o, vp0 + slot * 8192, pw);
            live = __any(carry != 0.0f);
        }
        const bool alive = (t > 0) && live;
        if (lane == 0) flags[(it & 1) * 8 + wid] = alive ? 1u : 0u;
        WAIT_BAR0();
        unsigned any = 0;
#pragma unroll
        for (int w = 0; w < 8; ++w) any |= flags[(it & 1) * 8 + w];
        if (!any) break;
    }
    float ones[16];
#pragma unroll
    for (int r = 0; r < 16; ++r) ones[r] = 1.0f;
    store_o(o, ones, (LAS f16*)(shm + AT_LOST) + wid * 2048, Odst + (rowbase + w0) * opitch + h * 64, opitch, lane);
#undef SB_DMA
}

constexpr int IX_NB = 1024;
constexpr int IX_NSLOT = 3;
constexpr int IX_HIST = 0;
constexpr int IX_RING = 32768;
constexpr int IX_BIG = IX_HIST;
constexpr int IX_MM = IX_RING + 8 * IX_NSLOT * 4096;
constexpr int IX_INFO = IX_MM + 512;
constexpr int IX_OVF = IX_INFO + 256;
constexpr int IX_CAND = IX_OVF + 16;
constexpr int IX_MB = IX_CAND + 4096;
constexpr int IX_LDS = IX_MB + 4096;
static_assert(IX_LDS <= PHASE_LDS, "indexer LDS");
#define IX_BAR() asm volatile("s_waitcnt lgkmcnt(0)\n\ts_barrier" ::: "memory")
__device__ __forceinline__ unsigned f2ord(float f) { const unsigned u = __float_as_uint(f); return u ^ ((unsigned)((int)u >> 31) | 0x80000000u); }
__device__ __forceinline__ float ord2f(unsigned k) { return __uint_as_float(k ^ ((k >> 31) ? 0x80000000u : 0xFFFFFFFFu)); }
template <int CTRL, int ROWMASK> __device__ __forceinline__ unsigned dpp_z(unsigned x) { return (unsigned)__builtin_amdgcn_update_dpp(0, (int)x, CTRL, ROWMASK, 0xf, false); }
template <int CTRL> __device__ __forceinline__ float dpp_f(float x) { return __uint_as_float((unsigned)__builtin_amdgcn_update_dpp((int)__float_as_uint(x), (int)__float_as_uint(x), CTRL, 0xf, 0xf, false)); }
#define LDS_ADD(p, v) __hip_atomic_fetch_add((p), (v), __ATOMIC_RELAXED, __HIP_MEMORY_SCOPE_WORKGROUP)

__device__ __forceinline__ void indexer_front(int b, int tau, const f16* QI, const f16* KI, const f16* WI, LAS unsigned char* shm, f16x8 (&aq)[2][4], f16x8 (&wraw)[2][2]) {
    int tid = threadIdx.x; asm volatile("" : "+v"(tid)); const int lane = tid & 63, r32 = lane & 31, hi = lane >> 5; const int wid = __builtin_amdgcn_readfirstlane(tid >> 6);
    const int t0 = tau * 8, c = tau >> 3, NKB = 2 * (c + 1); const size_t rowg = (size_t)b * SEQ;
    const int j_ = r32 >> 3, hp = (r32 >> 2) & 1, i_ = r32 & 3, head = 4 * (j_ & 1) + i_, qq = 2 * (j_ >> 1) + hp;
#pragma unroll
    for (int rb = 0; rb < 2; ++rb)
#pragma unroll
        for (int ks = 0; ks < 4; ++ks) aq[rb][ks] = *(const f16x8*)(QI + (rowg + t0 + 4 * rb + qq) * 512 + head * 64 + 16 * ks + 8 * hi);
#pragma unroll
    for (int rb = 0; rb < 2; ++rb)
#pragma unroll
        for (int u = 0; u < 2; ++u) wraw[rb][u] = *(const f16x8*)(WI + (rowg + t0 + 4 * rb + hi + 2 * u) * 8);
    const int nkb_w = (NKB - wid + 7) >> 3;
    const unsigned ring0 = (unsigned)__builtin_amdgcn_readfirstlane((unsigned)(uintptr_t)shm + IX_RING + wid * (IX_NSLOT * 4096));
    const unsigned voff_e = (unsigned)(((lane >> 3) * P_KI + (((lane & 7) ^ (lane >> 4)) * 8)) * 2);
    const unsigned voff_o = (unsigned)(((lane >> 3) * P_KI + (((lane & 7) ^ (4 + (lane >> 4))) * 8)) * 2);
    const f16* kwave = KI + (rowg + (size_t)wid * 32) * P_KI;
#pragma unroll
    for (int st = 0; st < 2; ++st) if (st < nkb_w) { const f16* sb_ = kwave + (size_t)st * 256 * P_KI; const unsigned d_ = ring0 + st * 4096;
        glds16s(voff_e, sb_, d_); glds16s(voff_o, sb_ + 8 * P_KI, d_ + 1024); glds16s(voff_e, sb_ + 16 * P_KI, d_ + 2048); glds16s(voff_o, sb_ + 24 * P_KI, d_ + 3072); }
}
__device__ __forceinline__ void indexer_unit(int b, int tau, const f16* QI, const f16* KI, const f16* WI, unsigned* maskR, LAS unsigned char* shm, f16x8 (&aq)[2][4], f16x8 (&wraw)[2][2], bool has_next, int b_next, int tau_next) {
    int tid = threadIdx.x; asm volatile("" : "+v"(tid)); const int lane = tid & 63, r32 = lane & 31, hi = lane >> 5; const int wid = __builtin_amdgcn_readfirstlane(tid >> 6);
    const int t0 = tau * 8, c = tau >> 3, NKB = 2 * (c + 1), N = 64 * (c + 1);
    const size_t rowg = (size_t)b * SEQ;
    LAS unsigned* hist = (LAS unsigned*)(shm + IX_HIST);
    LAS unsigned* mmx = (LAS unsigned*)(shm + IX_MM);
    LAS unsigned* info = (LAS unsigned*)(shm + IX_INFO);
    LAS unsigned* ovf = (LAS unsigned*)(shm + IX_OVF);
    LAS u32x2* cand = (LAS u32x2*)(shm + IX_CAND);
    LAS unsigned* mb = (LAS unsigned*)(shm + IX_MB);
    LAS u32x2* big = (LAS u32x2*)(shm + IX_BIG);
    if (N > TOPK) {
#pragma unroll
        for (int j = 0; j < 4; ++j) *(LAS u32x4*)(shm + IX_HIST + (j * 512 + tid) * 16) = (u32x4){0u, 0u, 0u, 0u};
    }
    if (tid < 68) info[tid] = 0u;
    if (tid < 16) mmx[tid] = 0u;
    mb[tid] = 0u; mb[tid + 512] = 0u;
    float sf[2][16][2];
    const int nkb_w = (NKB - wid + 7) >> 3;
    const unsigned ring0 = (unsigned)__builtin_amdgcn_readfirstlane((unsigned)(uintptr_t)shm + IX_RING + wid * (IX_NSLOT * 4096));
    const unsigned voff_e = (unsigned)(((lane >> 3) * P_KI + (((lane & 7) ^ (lane >> 4)) * 8)) * 2);
    const unsigned voff_o = (unsigned)(((lane >> 3) * P_KI + (((lane & 7) ^ (4 + (lane >> 4))) * 8)) * 2);
    const f16* kwave = KI + (rowg + (size_t)wid * 32) * P_KI;
#define IX_DMA(step, slot) do { const f16* sb_ = kwave + (size_t)(step) * 256 * P_KI; const unsigned d_ = ring0 + (slot) * 4096; \
        glds16s(voff_e, sb_, d_); glds16s(voff_o, sb_ + 8 * P_KI, d_ + 1024); glds16s(voff_e, sb_ + 16 * P_KI, d_ + 2048); glds16s(voff_o, sb_ + 24 * P_KI, d_ + 3072); } while (0)
    const lds_cptr rrd = (lds_cptr)shm + IX_RING + wid * (IX_NSLOT * 4096) + r32 * 128;
    const int rsw = (r32 >> 1) & 7;
    f32x16 dd[2][2];
#define IX_FRAG_MFMA(step, dst) do { f16x8 bk[4]; _Pragma("unroll") for (int ks = 0; ks < 4; ++ks) bk[ks] = *(const LAS f16x8*)(rrd + ((step) % IX_NSLOT) * 4096 + (((2 * ks + hi) ^ rsw) * 16)); \
        _Pragma("unroll") for (int rb = 0; rb < 2; ++rb) { f32x16 d = f32x16{}; _Pragma("unroll") for (int ks = 0; ks < 4; ++ks) d = MFMA32(aq[rb][ks], bk[ks], d); dst[rb] = d; } } while (0)
    if (0 < nkb_w) { if (1 < nkb_w) asm volatile("s_waitcnt vmcnt(4)" ::: "memory"); else asm volatile("s_waitcnt vmcnt(0)" ::: "memory"); IX_FRAG_MFMA(0, dd[0]); }
    float wq[2][2][8];
#pragma unroll
    for (int rb = 0; rb < 2; ++rb)
#pragma unroll
        for (int u = 0; u < 2; ++u)
#pragma unroll
            for (int hh = 0; hh < 8; ++hh) wq[rb][u][hh] = (float)wraw[rb][u][hh];
#pragma unroll
    for (int i = 0; i < 16; ++i) {
        if (i < nkb_w) {
            if (i + 2 < nkb_w) { asm volatile("s_waitcnt lgkmcnt(0)" ::: "memory"); IX_DMA(i + 2, (i + 2) % IX_NSLOT); }
            if (i + 1 < nkb_w) { if (i + 2 < nkb_w) asm volatile("s_waitcnt vmcnt(4)" ::: "memory"); else asm volatile("s_waitcnt vmcnt(0)" ::: "memory");
                IX_FRAG_MFMA(i + 1, dd[(i + 1) & 1]); }
#pragma unroll
            for (int rb = 0; rb < 2; ++rb)
#pragma unroll
                for (int u = 0; u < 2; ++u) { float s = 0.f;
#pragma unroll
                    for (int hh = 0; hh < 8; ++hh) { const int xb_ = (int)__float_as_uint(dd[i & 1][rb][8 * u + hh]); s = __builtin_fmaf(__uint_as_float((unsigned)(xb_ > 0 ? xb_ : 0)), wq[rb][u][hh], s); }
                    sf[rb][i][u] = s; }
        } else { sf[0][i][0] = 0.f; sf[0][i][1] = 0.f; sf[1][i][0] = 0.f; sf[1][i][1] = 0.f; }
    }
    asm volatile("s_waitcnt lgkmcnt(0)" ::: "memory");
#undef IX_FRAG_MFMA
    if (has_next) indexer_front(b_next, tau_next, QI, KI, WI, shm, aq, wraw);
#undef IX_DMA
    float T[4] = {0.f, 0.f, 0.f, 0.f}; unsigned It[4] = {4095u, 4095u, 4095u, 4095u}; bool dup = false;
    if (N > TOPK) {
        float scale[4], c0[4];
        { float mn[4], mx[4];
#pragma unroll
            for (int s = 0; s < 4; ++s) { float a = sf[s >> 1][0][s & 1], z = a;
#pragma unroll
                for (int i = 1; i < 16; ++i) if (wid + 8 * i < NKB) { a = fminf(a, sf[s >> 1][i][s & 1]); z = fmaxf(z, sf[s >> 1][i][s & 1]); }
                a = fminf(a, dpp_f<0xB1>(a)); z = fmaxf(z, dpp_f<0xB1>(z));
                a = fminf(a, dpp_f<0x4E>(a)); z = fmaxf(z, dpp_f<0x4E>(z));
                a = fminf(a, dpp_f<0x141>(a)); z = fmaxf(z, dpp_f<0x141>(z));
                a = fminf(a, dpp_f<0x140>(a)); z = fmaxf(z, dpp_f<0x140>(z));
                a = fminf(a, dpp_f<0x142>(a)); z = fmaxf(z, dpp_f<0x142>(z));
                mn[s] = a; mx[s] = z; }
            if (r32 == 31) {
#pragma unroll
                for (int s = 0; s < 4; ++s) { __hip_atomic_fetch_max(&mmx[(2 * s + hi) * 2 + 0], f2ord(mx[s]), __ATOMIC_RELAXED, __HIP_MEMORY_SCOPE_WORKGROUP);
                                              __hip_atomic_fetch_max(&mmx[(2 * s + hi) * 2 + 1], f2ord(-mn[s]), __ATOMIC_RELAXED, __HIP_MEMORY_SCOPE_WORKGROUP); } }
            IX_BAR();
#pragma unroll
            for (int s = 0; s < 4; ++s) { const u32x2 w_ = *(const LAS u32x2*)(mmx + (2 * s + hi) * 2); const float z = ord2f(w_.x), a = -ord2f(w_.y);
                scale[s] = (z > a) ? (float)(IX_NB - 1) / (z - a) : 0.f; c0[s] = -a * scale[s]; } }
        { unsigned hb[4];
#pragma unroll
            for (int s = 0; s < 4; ++s) hb[s] = (unsigned)(uintptr_t)shm + IX_HIST + (2 * s + hi) * (IX_NB * 4);
#pragma unroll
            for (int i = 0; i < 16; ++i) if (wid + 8 * i < NKB) {
#pragma unroll
                for (int s = 0; s < 4; ++s) { int bin = (int)__builtin_fmaf(sf[s >> 1][i][s & 1], scale[s], c0[s]); bin = bin > IX_NB - 1 ? IX_NB - 1 : bin;
                    LDS_ADD((LAS unsigned*)(uintptr_t)(hb[s] + 4u * (unsigned)bin), 1u); } } }
        IX_BAR();
        { const int q = wid, lb = 16 * (63 - lane); unsigned h[16]; unsigned tot = 0u;
#pragma unroll
            for (int k4 = 0; k4 < 4; ++k4) { const u32x4 w_ = *(const LAS u32x4*)(shm + IX_HIST + (q * IX_NB + lb + 4 * k4) * 4);
                h[4 * k4] = w_.x; h[4 * k4 + 1] = w_.y; h[4 * k4 + 2] = w_.z; h[4 * k4 + 3] = w_.w; tot += (w_.x + w_.y) + (w_.z + w_.w); }
            unsigned x = tot;
            x += dpp_z<0x111, 0xf>(x); x += dpp_z<0x112, 0xf>(x); x += dpp_z<0x114, 0xf>(x); x += dpp_z<0x118, 0xf>(x);
            x += dpp_z<0x142, 0xa>(x); x += dpp_z<0x143, 0xc>(x);
            unsigned cum = x - tot, bsel = 0u, abv = 0u; bool hit = false;
#pragma unroll
            for (int k = 15; k >= 0; --k) { const unsigned prev = cum; cum += h[k]; const bool t_ = prev < (unsigned)TOPK && cum >= (unsigned)TOPK;
                bsel = t_ ? (unsigned)(lb + k) : bsel; abv = t_ ? prev : abv; hit |= t_; }
            if (hit) { info[q * 8 + 0] = bsel; info[q * 8 + 1] = abv; } }
        IX_BAR();
        { float lo[4], hi_[4];
#pragma unroll
            for (int s = 0; s < 4; ++s) { const unsigned bs = info[(2 * s + hi) * 8 + 0]; lo[s] = bs == 0u ? -INFINITY : (float)bs; hi_[s] = bs == (unsigned)(IX_NB - 1) ? INFINITY : __uint_as_float(__float_as_uint((float)(bs + 1u)) - 1u); }
#pragma unroll
            for (int i = 0; i < 16; ++i) if (wid + 8 * i < NKB) {
#pragma unroll
                for (int s = 0; s < 4; ++s) { const float v = sf[s >> 1][i][s & 1]; const float t_ = __builtin_fmaf(v, scale[s], c0[s]);
                    if (__builtin_amdgcn_fmed3f(t_, lo[s], hi_[s]) == t_) { const int q = 2 * s + hi; const unsigned pos = LDS_ADD(&info[q * 8 + 2], 1u);
                        if (pos < 64u) cand[q * 64 + pos] = (u32x2){__float_as_uint(v), (unsigned)((wid + 8 * i) * 32 + r32)}; } } } }
        IX_BAR();
        { const int q = wid; const unsigned n = info[q * 8 + 2], need = (unsigned)TOPK - info[q * 8 + 1];
            if (n <= 64u) {
                const u32x2 cv = cand[q * 64 + lane]; const bool act = (unsigned)lane < n; const float v = __uint_as_float(cv.x); const unsigned key = cv.y;
                unsigned rank = 0u;
                for (unsigned j = 0; j < n; ++j) { const float vj = __uint_as_float(__builtin_amdgcn_readlane(cv.x, j)); const unsigned kj = __builtin_amdgcn_readlane(cv.y, j);
                    rank += (vj > v || (vj == v && kj < key)) ? 1u : 0u; }
                const bool isT = act && rank == need - 1u;
                const unsigned long long mT = __ballot(isT);
                if (mT) { const int src = __builtin_ctzll(mT); const float Tv = __uint_as_float(__builtin_amdgcn_readlane(cv.x, src));
                    const unsigned long long me = __ballot(act && v == Tv);
                    if (isT) { info[q * 8 + 3] = cv.x; info[q * 8 + 4] = key; info[q * 8 + 5] = (__builtin_popcountll(me) > 1) ? 1u : 0u; } }
            } else if (lane == 0) ovf[0] = 1u;
        }
        IX_BAR();
        if (ovf[0] != 0u) {
            for (int q = 0; q < 8; ++q) {
                const unsigned n = info[q * 8 + 2];
                if (n > 64u) {
                    IX_BAR();
                    if (tid == 0) info[q * 8 + 6] = 0u;
                    IX_BAR();
                    const unsigned bstq = info[q * 8 + 0]; const float loq = bstq == 0u ? -INFINITY : (float)bstq, hiq = bstq == (unsigned)(IX_NB - 1) ? INFINITY : (float)(bstq + 1u);
                    if ((q & 1) == hi) { const int s = q >> 1;
#pragma unroll
                        for (int i = 0; i < 16; ++i) if (wid + 8 * i < NKB) {
#pragma unroll
                            for (int s2 = 0; s2 < 4; ++s2) if (s2 == s) { float c0o = c0[s2]; asm volatile("" : "+v"(c0o));
                                const float v = sf[s2 >> 1][i][s2 & 1]; const float t_ = __builtin_fmaf(v, scale[s2], c0o);
                                if (t_ >= loq && t_ < hiq) { const unsigned pos = LDS_ADD(&info[q * 8 + 6], 1u); big[pos] = (u32x2){__float_as_uint(v), (unsigned)((wid + 8 * i) * 32 + r32)}; } } } }
                    IX_BAR();
                    const unsigned need = (unsigned)TOPK - info[q * 8 + 1];
                    for (unsigned e = tid; e < n; e += 512u) { const u32x2 ce = big[e]; const float v = __uint_as_float(ce.x); unsigned rank = 0u;
                        for (unsigned j = 0; j < n; ++j) { const u32x2 cj = big[j]; const float vj = __uint_as_float(cj.x); rank += (vj > v || (vj == v && cj.y < ce.y)) ? 1u : 0u; }
                        if (rank == need - 1u) { info[q * 8 + 3] = ce.x; info[q * 8 + 4] = ce.y; info[q * 8 + 5] = 1u; } }
                    IX_BAR();
                }
            }
        }
#pragma unroll
        for (int s = 0; s < 4; ++s) { T[s] = __uint_as_float(info[(2 * s + hi) * 8 + 3]); It[s] = info[(2 * s + hi) * 8 + 4]; }
        dup = (info[5] | info[13] | info[21] | info[29] | info[37] | info[45] | info[53] | info[61]) != 0u;
    } else IX_BAR();
    { unsigned accA = 0u, accB = 0u;
#define IX_SELECT(PRED) do { _Pragma("unroll") for (int i = 0; i < 16; ++i) { const int kb = wid + 8 * i; if (kb < NKB) { const unsigned key = (unsigned)(kb * 32 + r32); (void)key; \
            _Pragma("unroll") for (int s = 0; s < 4; ++s) { const float v = sf[s >> 1][i][s & 1]; (void)v; const unsigned long long m = __ballot(PRED); \
                asm volatile("s_nop 3\n\tv_writelane_b32 %0, %2, %4\n\tv_writelane_b32 %1, %3, %4" : "+v"(accA), "+v"(accB) : "s"((unsigned)m), "s"((unsigned)(m >> 32)), "i"(4 * i + s)); } } } } while (0)
        if (N <= TOPK) IX_SELECT(true);
        else if (!dup) IX_SELECT(v >= T[s]);
        else IX_SELECT(v > T[s] || (v == T[s] && key <= It[s]));
#undef IX_SELECT
        const int kbl = wid + 8 * (lane >> 2), sl = lane & 3;
        if (kbl < NKB) { mb[(2 * sl) * 128 + kbl] = accA; mb[(2 * sl + 1) * 128 + kbl] = accB; } }
    IX_BAR();
    { const int q = tid >> 7, kbb = tid & 127; maskR[(rowg + t0 + q) * 128 + kbb] = mb[tid]; maskR[(rowg + t0 + 4 + q) * 128 + kbb] = mb[tid + 512]; }
}
namespace spa {
typedef short s16x8_t __attribute__((ext_vector_type(8)));
constexpr int NSLOT = 3, SLOTB = 8192;
constexpr int L_K = 0, L_V = NSLOT * SLOTB, L_WS = 2 * NSLOT * SLOTB, L_OST = L_WS + 8 * 256, L_TBL = L_OST + 8 * 4096, L_MSK = L_TBL + 4096, L_END = L_MSK + 8 * 2048;
static_assert(L_END <= PHASE_LDS, "sparse attention LDS");
constexpr int TBL_OFF = 448;
#define SPA_SBAR() __builtin_amdgcn_sched_barrier(0)
#define SPA_WAIT_BAR(N) asm volatile("s_waitcnt vmcnt(" #N ") lgkmcnt(0)\n\ts_barrier" ::: "memory")
#define SPA_MFMA(a, b, c) __builtin_amdgcn_mfma_f32_32x32x16_f16(a, b, c, 0, 0, 0)
__device__ __forceinline__ void kload2(f16x8* kf, lds_cptr kp, int j) { kf[2 * j] = *(const LAS f16x8*)(kp + j * 2048); kf[2 * j + 1] = *(const LAS f16x8*)(kp + j * 2048 + 512); }
__device__ __forceinline__ float mskf(float p, int bits, int k) { return __uint_as_float(__float_as_uint(p) & (unsigned)__builtin_amdgcn_sbfe(bits, k, 1)); }
template <int K> __device__ __forceinline__ unsigned bfe1(int bits) { unsigned m; asm("v_bfe_i32 %0, %1, %2, 1" : "=v"(m) : "v"(bits), "n"(K)); return m; }

__device__ __forceinline__ void unit(int b, int h, int qb, const f16* QKV, f16* Odst, int opitch, const unsigned* maskR, const float* relb, LAS unsigned char* shm, bool build_table) {
    int tid = threadIdx.x; asm volatile("" : "+v"(tid)); const int lane = tid & 63, r32 = lane & 31, hi = lane >> 5; const int wid = __builtin_amdgcn_readfirstlane(tid >> 6);
    const size_t rowbase = (size_t)b * SEQ; const int Q0 = qb * 256, w0 = Q0 + wid * 32, NT = 4 * qb + 4;
    const f16* Qw = QKV + (rowbase + w0) * P_QKV + h * 64;
    const f16* ksrc = QKV + (rowbase + lane) * P_QKV + 512 + h * 64 + wid * 8;
    const f16* vsrc = QKV + (rowbase + 16 * (wid & 3) + (lane >> 2)) * P_QKV + 1024 + h * 64 + (wid >> 2) * 32 + (lane & 3) * 8;
    const unsigned lds0 = (unsigned)(uintptr_t)shm;
    const unsigned kdst = lds0 + L_K + wid * 1024, vdst = lds0 + L_V + wid * 1024;
#define DMA_K(t, slot) glds16(ksrc + (size_t)(t) * 64 * P_QKV, (unsigned)__builtin_amdgcn_readfirstlane(kdst + (slot)))
#define DMA_V(t, slot) glds16(vsrc + (size_t)(t) * 64 * P_QKV, (unsigned)__builtin_amdgcn_readfirstlane(vdst + (slot)))
    const unsigned* msrc = maskR + (rowbase + w0 + r32) * 128 + 4 * hi;
    const unsigned mdst = lds0 + L_MSK + wid * 2048;
#define DMA_M(g) glds16(msrc + 8 * (g), (unsigned)__builtin_amdgcn_readfirstlane(mdst + ((g) & 1) * 1024))
    const lds_cptr mrd = (lds_cptr)shm + L_MSK + wid * 2048 + r32 * 16;
#define MASK_LD(t) (*(const LAS u32x2*)(mrd + ((((t) >> 2) & 1) * 1024 + (((t) >> 1) & 1) * 512 + ((t) & 1) * 8)))
    LAS float* wsf = (LAS float*)(shm + L_WS) + wid * 64;
    LAS float* tbl = (LAS float*)(shm + L_TBL);
    if (build_table) for (int i = tid; i < 1024; i += 512) { const int rel = i - TBL_OFF, n = rel < 0 ? -rel : rel; int bk = n < 8 ? n : 2 + (31 - __builtin_clz((unsigned)(n * n))); bk = bk > 15 ? 15 : bk;
        tbl[i] = relb[((rel > 0 ? 16 : 0) + bk) * NH + h] * LOG2E; }
    const float cfar = relb[15 * NH + h] * LOG2E;
    const lds_cptr shm3 = (lds_cptr)shm; const lds_cptr kp0 = shm3 + L_K + hi * 1024 + r32 * 16;
    const lds_cptr vp0 = shm3 + L_V + ((lane >> 4) & 1) * 32 + (lane & 3) * 8 + (4 * hi + ((lane & 15) >> 2)) * 64;
    const LAS float* tb0 = tbl + (4 * hi - (w0 + r32) + TBL_OFF);
    DMA_M(0); DMA_K(0, 0); DMA_V(0, 0); DMA_K(1, SLOTB);
    f16x8 qr[4];
#pragma unroll
    for (int d0 = 0; d0 < 4; ++d0) qr[d0] = *(const f16x8*)(Qw + (size_t)r32 * P_QKV + d0 * 16 + hi * 8);
    float mhat = 0.f, l_reg = 0.f; f32x16 o[2]; o[0] = f32x16{}; o[1] = f32x16{}; f32x16 negm; { float z_ = 0.f; asm volatile("" : "+v"(z_)); _Pragma("unroll") for (int r = 0; r < 16; ++r) negm[r] = z_; }
    bool resc = false; f16x8 kf[8];
    const bool steady = (NT > 8);
#define BIAS_NEAR(P0, P1, t) do { const LAS float* tb_ = tb0 + 64 * (t); _Pragma("unroll") for (int r = 0; r < 16; ++r) { const int kc = (r & 3) + 8 * (r >> 2); P0[r] += tb_[kc]; P1[r] += tb_[32 + kc]; } } while (0)
#define RESC() do { if (resc) { asm volatile("s_waitcnt lgkmcnt(0)" ::: "memory"); \
        _Pragma("unroll") for (int d_ = 0; d_ < 2; ++d_) _Pragma("unroll") for (int r = 0; r < 16; ++r) o[d_][r] *= wsf[crow(r, hi)]; } } while (0)
    f32x16 pA0, pA1, pB0, pB1;
    int sl_prev = 0, sl_cur = 0, sl_next = SLOTB;
#define ROT() do { sl_prev = sl_cur; sl_cur = sl_next; sl_next = (sl_next == (NSLOT - 1) * SLOTB) ? 0 : sl_next + SLOTB; } while (0)
    DMA_K(2, 2 * SLOTB);
    SPA_WAIT_BAR(3);
    { const lds_cptr kb = kp0;
#pragma unroll
        for (int d0 = 0; d0 < 4; ++d0) { const f16x8 b0 = *(const LAS f16x8*)(kb + d0 * 2048), b1 = *(const LAS f16x8*)(kb + d0 * 2048 + 512);
            if (d0 == 0) { pA0 = SPA_MFMA(b0, qr[0], negm); pA1 = SPA_MFMA(b1, qr[0], negm); } else { pA0 = SPA_MFMA(b0, qr[d0], pA0); pA1 = SPA_MFMA(b1, qr[d0], pA1); } }
        asm volatile("s_nop 15\n\ts_nop 7" : "+v"(pA0), "+v"(pA1));
        if (qb == 0) BIAS_NEAR(pA0, pA1, 0);
        else {
#pragma unroll
            for (int r = 0; r < 16; ++r) { pA0[r] += cfar; pA1[r] += cfar; } }
        const float rm = rowmax32(pA0, pA1); mhat = rm; const float cb = steady ? cfar : 0.f;
#pragma unroll
        for (int r = 0; r < 16; ++r) negm[r] = cb - mhat;
        asm volatile("" : "+v"(negm));
        const u32x2 mw = MASK_LD(0); const int mlo = (int)(mw.x >> (4 * hi)), mhi = (int)(mw.y >> (4 * hi));
#pragma unroll
        for (int r = 0; r < 16; ++r) { const int kc = (r & 3) + 8 * (r >> 2); pA0[r] = mskf(__builtin_amdgcn_exp2f(pA0[r] - rm), mlo, kc); pA1[r] = mskf(__builtin_amdgcn_exp2f(pA1[r] - rm), mhi, kc); }
    }
    SPA_WAIT_BAR(0);
    if (NT > 4) DMA_M(1);
    DMA_K(3, 0); DMA_V(1, SLOTB);
    ROT();
    { const lds_cptr kp = kp0 + sl_cur; kf[0] = *(const LAS f16x8*)(kp); kf[1] = *(const LAS f16x8*)(kp + 512); kf[2] = *(const LAS f16x8*)(kp + 2048); kf[3] = *(const LAS f16x8*)(kp + 2560);
      kf[4] = *(const LAS f16x8*)(kp + 4096); kf[5] = *(const LAS f16x8*)(kp + 4608); kf[6] = *(const LAS f16x8*)(kp + 6144); kf[7] = *(const LAS f16x8*)(kp + 6656); }
    SPA_WAIT_BAR(2);
    s16x4 vlo[8], vhi[8]; u32x4 pw0, pw1, pw2, pw3;
#define PKW(P, B) pk2h(P[B], P[B + 1])
#define PAF(k) __builtin_bit_cast(f16x8, pw##k)
#define VFR(i) __builtin_bit_cast(f16x8, (s16x8_t){vlo[i][0], vlo[i][1], vlo[i][2], vlo[i][3], vhi[i][0], vhi[i][1], vhi[i][2], vhi[i][3]})
#define PIN(x) asm volatile("" : "+v"(x))
#define MX3(a, b, c) __builtin_fmaxf(__builtin_fmaxf((a), (b)), (c))
#define PR2(P, i) __builtin_shufflevector(P, P, i, (i) + 1)
#define GAPA(MF, PA, ia, PB, ib, W0, W1, PW) do { MF; sacc += PR2(PA, ia); if ((ib) >= 0) sacc += PR2(PB, (ib) < 0 ? 0 : (ib)); PIN(sacc); W0; W1; PIN(PW); SPA_SBAR(); } while (0)
#define KC_(B) (((B) & 3) + 8 * ((B) >> 2))
#define GAPB(MF, X, B, MW) do { MF; const float e0_ = __builtin_amdgcn_exp2f(X[B]), e1_ = __builtin_amdgcn_exp2f(X[(B) + 1]), e2_ = __builtin_amdgcn_exp2f(X[(B) + 2]), e3_ = __builtin_amdgcn_exp2f(X[(B) + 3]); \
        const unsigned m0_ = bfe1<KC_(B)>(MW), m1_ = bfe1<KC_((B) + 1)>(MW), m2_ = bfe1<KC_((B) + 2)>(MW), m3_ = bfe1<KC_((B) + 3)>(MW); \
        X[B] = __uint_as_float(__float_as_uint(e0_) & m0_); X[(B) + 1] = __uint_as_float(__float_as_uint(e1_) & m1_); X[(B) + 2] = __uint_as_float(__float_as_uint(e2_) & m2_); X[(B) + 3] = __uint_as_float(__float_as_uint(e3_) & m3_); \
        PIN(X); SPA_SBAR(); } while (0)
#define VRD(i) do { vlo[i] = vtr(vp_ + (((i) >> 2) * 4096 + ((i) & 3) * 1024)); vhi[i] = vtr(vp_ + (((i) >> 2) * 4096 + ((i) & 3) * 1024 + 512)); } while (0)
#define KRD(G, j) do { if (G) { kload2(kf, kp0 + sl_next, j); SPA_SBAR(); } } while (0)
#define STEP(C0, C1, P0, P1, t, GK, GV, GL, NEAR, CB) do { SPA_SBAR(); \
    const lds_cptr vp_ = vp0 + sl_prev; const u32x2 mw_ = MASK_LD(t); const int mlo_ = (int)(mw_.x >> (4 * hi)), mhi_ = (int)(mw_.y >> (4 * hi)); \
    VRD(0); SPA_SBAR(); f32x2 sacc = (f32x2){P0[0], P0[1]}; \
    GAPA(C0 = SPA_MFMA(kf[0], qr[0], negm), P0, 2, P0, 4,     pw0[0] = PKW(P0, 0), pw0[1] = PKW(P0, 2), pw0); \
    VRD(4); SPA_SBAR(); GAPA(C1 = SPA_MFMA(kf[1], qr[0], negm), P0, 6, P0, 8,     pw0[2] = PKW(P0, 4), pw0[3] = PKW(P0, 6), pw0); \
    VRD(1); SPA_SBAR(); GAPA(C0 = SPA_MFMA(kf[2], qr[1], C0),   P0, 10, P0, 12, pw1[0] = PKW(P0, 8), pw1[1] = PKW(P0, 10), pw1); \
    VRD(5); SPA_SBAR(); GAPA(C1 = SPA_MFMA(kf[3], qr[1], C1),   P0, 14, P1, 0,   pw1[2] = PKW(P0, 12), pw1[3] = PKW(P0, 14), pw1); \
    VRD(2); SPA_SBAR(); GAPA(C0 = SPA_MFMA(kf[4], qr[2], C0),   P1, 2, P1, 4,     pw2[0] = PKW(P1, 0), pw2[1] = PKW(P1, 2), pw2); \
    VRD(6); SPA_SBAR(); GAPA(C1 = SPA_MFMA(kf[5], qr[2], C1),   P1, 6, P1, 8,     pw2[2] = PKW(P1, 4), pw2[3] = PKW(P1, 6), pw2); \
    VRD(3); SPA_SBAR(); GAPA(C0 = SPA_MFMA(kf[6], qr[3], C0),   P1, 10, P1, 12, pw3[0] = PKW(P1, 8), pw3[1] = PKW(P1, 10), pw3); \
    VRD(7); SPA_SBAR(); GAPA(C1 = SPA_MFMA(kf[7], qr[3], C1),   P1, 14, P1, -1,       pw3[2] = PKW(P1, 12), pw3[3] = PKW(P1, 14), pw3); \
    l_reg += sacc.x + sacc.y; \
    if ((((t) & 3) == 0) && ((t) + 4 < NT)) { DMA_M(((t) >> 2) + 1); } \
    if (GK) { DMA_K((t) + 3, sl_cur); } if (GV) { DMA_V((t) + 1, sl_next); } \
    if (NEAR) { asm volatile("s_nop 15\n\ts_nop 7" : "+v"(C0), "+v"(C1)); BIAS_NEAR(C0, C1, t); } \
    { float a = MX3(C0[0], C0[1], C1[0]), bq = MX3(C0[2], C0[3], C1[1]); a = MX3(a, C1[2], C1[3]); \
      _Pragma("unroll") for (int r = 4; r < 16; r += 4) { a = MX3(a, C0[r], C0[r + 1]); bq = MX3(bq, C0[r + 2], C0[r + 3]); a = MX3(a, C1[r], C1[r + 1]); bq = MX3(bq, C1[r + 2], C1[r + 3]); } \
      float rm = __builtin_fmaxf(a, bq); { auto rr = __builtin_amdgcn_permlane32_swap(__float_as_uint(rm), __float_as_uint(rm), false, false); rm = __builtin_fmaxf(__uint_as_float(rr[0]), __uint_as_float(rr[1])); } \
      resc = false; \
      if (__builtin_expect(__any(rm > 8.0f), 0)) { const float dl = __builtin_fmaxf(rm, 0.f); mhat += dl; \
        _Pragma("unroll") for (int r = 0; r < 16; ++r) { C0[r] -= dl; C1[r] -= dl; } \
        _Pragma("unroll") for (int r = 0; r < 16; ++r) negm[r] = (CB) - mhat; asm volatile("" : "+v"(negm)); \
        const float f = __builtin_amdgcn_exp2f(-dl); l_reg *= f; if (hi == 0) wsf[r32] = f; resc = true; } } \
    SPA_SBAR(); \
    GAPB(o[0] = SPA_MFMA(PAF(0), VFR(0), o[0]), C0, 0, mlo_); \
    GAPB(o[1] = SPA_MFMA(PAF(0), VFR(4), o[1]), C0, 4, mlo_); \
    KRD(GL, 0); GAPB(o[0] = SPA_MFMA(PAF(1), VFR(1), o[0]), C0, 8, mlo_); \
    KRD(GL, 1); GAPB(o[1] = SPA_MFMA(PAF(1), VFR(5), o[1]), C0, 12, mlo_); \
    KRD(GL, 2); GAPB(o[0] = SPA_MFMA(PAF(2), VFR(2), o[0]), C1, 0, mhi_); \
    KRD(GL, 3); GAPB(o[1] = SPA_MFMA(PAF(2), VFR(6), o[1]), C1, 4, mhi_); \
    GAPB(o[0] = SPA_MFMA(PAF(3), VFR(3), o[0]), C1, 8, mhi_); \
    GAPB(o[1] = SPA_MFMA(PAF(3), VFR(7), o[1]), C1, 12, mhi_); \
    } while (0)
    int t = 1;
    for (; t + 7 < NT; t += 2) {
        STEP(pB0, pB1, pA0, pA1, t, true, true, true, false, cfar);     SPA_WAIT_BAR(2); RESC(); ROT();
        STEP(pA0, pA1, pB0, pB1, t + 1, true, true, true, false, cfar); SPA_WAIT_BAR(2); RESC(); ROT();
    }
    if (steady) {
#pragma unroll
        for (int r = 0; r < 16; ++r) negm[r] = -mhat;
        asm volatile("" : "+v"(negm)); }
#define ENDW(tt) do { if ((tt) + 3 < NT) { SPA_WAIT_BAR(2); } else if ((tt) + 2 < NT) { SPA_WAIT_BAR(1); } else { SPA_WAIT_BAR(0); } } while (0)
    for (; t + 1 < NT; t += 2) {
        STEP(pB0, pB1, pA0, pA1, t, (t + 3 < NT), (t + 1 < NT), (t + 1 < NT), true, 0.f);         ENDW(t);     RESC(); ROT();
        STEP(pA0, pA1, pB0, pB1, t + 1, (t + 4 < NT), (t + 2 < NT), (t + 2 < NT), true, 0.f);     ENDW(t + 1); RESC(); ROT();
    }
    STEP(pB0, pB1, pA0, pA1, NT - 1, false, false, false, true, 0.f); RESC();
    { float sacc = pB0[0] + pB0[1];
#pragma unroll
        for (int r = 2; r < 16; ++r) sacc += pB0[r];
#pragma unroll
        for (int r = 0; r < 16; ++r) sacc += pB1[r];
        l_reg += sacc;
        u32x4 pw[4];
#pragma unroll
        for (int k = 0; k < 4; ++k) { pw[0][k] = pk2h(pB0[2 * k], pB0[2 * k + 1]); pw[1][k] = pk2h(pB0[8 + 2 * k], pB0[9 + 2 * k]); pw[2][k] = pk2h(pB1[2 * k], pB1[2 * k + 1]); pw[3][k] = pk2h(pB1[8 + 2 * k], pB1[9 + 2 * k]); }
        SPA_SBAR(); pv_tile(o, vp0 + sl_cur, pw); }
    { auto rr = __builtin_amdgcn_permlane32_swap(__float_as_uint(l_reg), __float_as_uint(l_reg), false, false); l_reg = __uint_as_float(rr[0]) + __uint_as_float(rr[1]); }
    if (hi == 0) wsf[32 + r32] = l_reg;
    asm volatile("s_waitcnt lgkmcnt(0)" ::: "memory");
    float rli[16];
#pragma unroll
    for (int r = 0; r < 16; ++r) rli[r] = __builtin_amdgcn_rcpf(wsf[32 + crow(r, hi)]);
    store_o(o, rli, (LAS f16*)(shm + L_OST) + wid * 2048, Odst + (rowbase + w0) * opitch + h * 64, opitch, lane);
    asm volatile("s_waitcnt lgkmcnt(0)\n\ts_barrier" ::: "memory");
#undef DMA_K
#undef DMA_V
#undef DMA_M
#undef MASK_LD
#undef BIAS_NEAR
#undef RESC
#undef ROT
#undef PKW
#undef PAF
#undef VFR
#undef PIN
#undef MX3
#undef GAPA
#undef PR2
#undef KC_
#undef GAPB
#undef VRD
#undef KRD
#undef STEP
#undef ENDW
}
}
#ifndef REP_GEMM
#define REP_GEMM 1
#endif
#ifndef REP_G_IN
#define REP_G_IN REP_GEMM
#endif
#ifndef REP_G_BR
#define REP_G_BR REP_GEMM
#endif
#ifndef REP_G_WO
#define REP_G_WO REP_GEMM
#endif
#ifndef REP_G_GU
#define REP_G_GU REP_GEMM
#endif
#ifndef REP_G_DN
#define REP_G_DN REP_GEMM
#endif
#ifndef REP_IDX
#define REP_IDX 1
#endif
#ifndef REP_SB
#define REP_SB 1
#endif
#ifndef REP_SP
#define REP_SP 1
#endif
#ifndef REP_NORM
#define REP_NORM 1
#endif
struct Args { const float* in[12]; float* out; unsigned char* ws; };
__global__ void __launch_bounds__(512, 2) fwd_kernel(Args args) {
    extern __shared__ __attribute__((aligned(16))) unsigned char lds_raw[];
    Frame F;
    F.lds = (LAS unsigned char*)lds_raw;
    F.MISC = (volatile LAS unsigned*)(F.lds + MISC_OFF);
    F.tid = threadIdx.x; F.lane = F.tid & 63; F.wave = __builtin_amdgcn_readfirstlane(F.tid >> 6);
    F.G = gridDim.x; { const int bx = blockIdx.x; F.vcu = (F.G % 8 == 0) ? (bx % 8) * (F.G / 8) + bx / 8 : bx; }
    GAS unsigned char* wsg = (GAS unsigned char*)args.ws;
    unsigned char* ws0 = (unsigned char*)wsg;
    F.ctl = (unsigned*)(ws0 + WS_CTL);
    if (F.tid < (LDS_BYTES - PHASE_LDS) / 4) ((LAS unsigned*)(F.lds + PHASE_LDS))[F.tid] = 0u;
    __syncthreads();
    XcdBarrier bar = xcd_barrier_post(F.ctl + CW_BAR, F.MISC + 8);
    Inputs I; I.x = args.in[0]; I.w_in = args.in[1]; I.w_a = args.in[2]; I.w_b = args.in[3]; I.w_o = args.in[4]; I.w_gu = args.in[5]; I.w_d = args.in[6];
    I.g_pre_mix = args.in[7]; I.g_post_mix = args.in[8]; I.g_pre_ffn = args.in[9]; I.g_post_ffn = args.in[10]; I.rel_bias = args.in[11];
    float* X = args.out;
    const int vcu = F.vcu;

    convert_weights(F, I, ws0, 0);
    norm_to_f16(F, I.x, I.g_pre_mix, (f16*)(ws0 + WS_H), ws0 + WS_H8);
    xcd_barrier(bar);

    for (int l = 0; l < DEPTH; ++l) {
        asm volatile("" : "+s"(wsg)); unsigned char* ws = (unsigned char*)wsg;
        f16* H = (f16*)(ws + WS_H); f16* QKVA = (f16*)(ws + WS_QKVA); f16* QI = (f16*)(ws + WS_QI); f16* KIW = (f16*)(ws + WS_KIW); f16* WIB = (f16*)(ws + WS_WI); f16* QKVB = (f16*)(ws + WS_QKVB);
        f16* GATES = (f16*)(ws + WS_GATES); f16* Y = (f16*)(ws + WS_GATES); unsigned* MASK = (unsigned*)(ws + WS_MASK); f16* HID = (f16*)(ws + WS_HID);
        const unsigned char* wt = ws + WS_WT;
        unsigned char* H8 = ws + WS_H8;
        f16* XA = (f16*)(ws + WS_QKVB); f16* XB = (f16*)X;
        { pg8::Gemm g{H, (const f16*)(wt + WT_IN), M, NIN16, DM, DM, nullptr, 0}; pg8::StaticOrder S; S.init(M, NIN16, F.G, (int)blockIdx.x);
          pg8::EpiProj E{QKVA, QI, KIW, WIB, QKVB};
          for (int rep = 0; rep < REP_G_IN; ++rep) pg8::gemm_phase<pg8::EpiProj, true>(F.lds, g, S, E); }
        { pg8::Gemm g{(const f16*)H8, (const f16*)(wt + WT_G8), M, 2048, DM / 2, DM / 2, nullptr, 0}; pg8::GateOrder S{(int)blockIdx.x};
          pg8::EpiGates8 E{GATES};
          for (int rep = 0; rep < REP_G_IN; ++rep) pg8::gemm_phase_t<pg8::EpiGates8, true, true, pg8::GateOrder>(F.lds, g, S, E); }
        xcd_barrier(bar);
        { const int b = vcu >> 5, r = vcu & 31;
          f16x8 aq[2][4]; f16x8 wq[2][2];
          for (int rep = 0; rep < REP_IDX; ++rep) { indexer_front(b, r, QI, KIW, WIB, F.lds, aq, wq);
            for (int k = 0; k < 16; ++k) { const int kn = k + 1; indexer_unit(b, 32 * k + ((k & 1) ? 31 - r : r), QI, KIW, WIB, MASK, F.lds, aq, wq, kn < 16, b, 32 * kn + ((kn & 1) ? 31 - r : r)); } } }
        { const int bh = vcu >> 2, s = vcu & 3;
          for (int rep = 0; rep < REP_SB; ++rep) for (int k = 0; k < 4; ++k) { const int qb = (k == 0) ? s : (k == 1) ? 7 - s : (k == 2) ? 8 + s : 15 - s;
            if (rep + 1 < REP_SB) sbattn_unit(bh >> 3, bh & 7, qb, QKVB, H, 512, F.lds); else sbattn_unit(bh >> 3, bh & 7, qb, QKVB, QKVB, P_QKV, F.lds); } }
        xcd_barrier(bar);
        { const int bh = vcu >> 2, s = vcu & 3;
          for (int rep = 0; rep < REP_SP; ++rep) for (int k = 0; k < 4; ++k) { const int qb = (k == 0) ? s : (k == 1) ? 7 - s : (k == 2) ? 8 + s : 15 - s;
            if (rep + 1 < REP_SP) spa::unit(bh >> 3, bh & 7, qb, QKVA, H, 512, MASK, I.rel_bias, F.lds, k == 0); else spa::unit(bh >> 3, bh & 7, qb, QKVA, QKVA, P_QKV, MASK, I.rel_bias, F.lds, k == 0); } }
        xcd_barrier(bar);
        for (int rep = 0; rep < REP_G_BR; ++rep) { pg8::StaticOrder S; S.init(M, DM, F.G, (int)blockIdx.x);
          pg8::Gemm g{QKVA, (const f16*)(wt + WT_A), M, DM, DM, P_QKV, QKVB, 8}; pg8::EpiGateMerged E{H, GATES}; pg8::gemm_phase<pg8::EpiGateMerged, true>(F.lds, g, S, E); }
        xcd_barrier(bar);
        { pg8::Gemm g{H, (const f16*)(wt + WT_O), M, DM, DM, DM, nullptr, 0}; pg8::StaticOrder S; S.init(M, DM, F.G, (int)blockIdx.x);
          pg8::EpiF16 E{Y, DM}; for (int rep = 0; rep < REP_G_WO; ++rep) pg8::gemm_phase<pg8::EpiF16, true>(F.lds, g, S, E); }
        xcd_barrier(bar);
        if (l == 0) norm_residual<false, true>(F, I.x, Y, I.g_post_mix + l * DM, XA, I.g_pre_ffn + l * DM, H, nullptr);
        else norm_residual<true, true>(F, XB, Y, I.g_post_mix + l * DM, XA, I.g_pre_ffn + l * DM, H, nullptr);
        xcd_barrier(bar);
        { pg8::Gemm g{H, (const f16*)(wt + WT_GU), M, NGU, DM, DM, nullptr, 0}; pg8::StaticOrder S; S.init(M, NGU, F.G, (int)blockIdx.x);
          pg8::EpiSwiglu8 E{(unsigned char*)HID}; for (int rep = 0; rep < REP_G_GU; ++rep) pg8::gemm_phase<pg8::EpiSwiglu8, true>(F.lds, g, S, E); }
        xcd_barrier(bar);
        { pg8::Gemm g{HID, (const f16*)(wt + WT_D), M, DM, DFF / 2, DFF / 2, nullptr, 0}; pg8::StaticOrder S; S.init(M, DM, F.G, (int)blockIdx.x);
          pg8::EpiF16S E{Y, DM, 1.0f / (pg8::HID_SCALE * pg8::WD_SCALE)}; for (int rep = 0; rep < REP_G_DN; ++rep) pg8::gemm_phase<pg8::EpiF16S, true, true>(F.lds, g, S, E); }
        xcd_barrier(bar);
        if (l + 1 < DEPTH) { norm_residual<true, true>(F, XA, Y, I.g_post_ffn + l * DM, XB, I.g_pre_mix + (l + 1) * DM, H, H8); convert_weights(F, I, ws, l + 1); xcd_barrier(bar); }
        else norm_residual<true, false>(F, XA, Y, I.g_post_ffn + l * DM, X, nullptr, nullptr, nullptr);
    }
}

extern "C" void kernel_launch(void* const* d_in, const int* in_sizes, int n_in, void* d_out, int out_size, void* d_ws, size_t ws_size, hipStream_t stream) {
    static int grid = 0;
    if (grid == 0) {
        if (n_in != 12 || out_size != M * DM || ws_size < WS_END) { fprintf(stderr, "kernel_launch: unexpected shapes (n_in %d, out %d, ws %zu); nothing launched\n", n_in, out_size, ws_size); grid = -1; return; }
        int dev = 0, cus = 0, per_cu = 0;
        if (hipGetDevice(&dev) != hipSuccess || hipDeviceGetAttribute(&cus, hipDeviceAttributeMultiprocessorCount, dev) != hipSuccess) { grid = -1; return; }
        if (hipFuncSetAttribute((const void*)fwd_kernel, hipFuncAttributeMaxDynamicSharedMemorySize, LDS_BYTES) != hipSuccess) { fprintf(stderr, "kernel_launch: hipFuncSetAttribute failed\n"); grid = -1; return; }
        if (hipOccupancyMaxActiveBlocksPerMultiprocessor(&per_cu, (const void*)fwd_kernel, 512, LDS_BYTES) != hipSuccess || per_cu < 1) fprintf(stderr, "kernel_launch: occupancy query reports %d workgroups per CU\n", per_cu);
        (void)hipGetLastError();
        if (cus < 256) { fprintf(stderr, "kernel_launch: %d CUs; this kernel's unit deals need 256 co-resident workgroups; nothing launched\n", cus); grid = -1; return; }
        grid = 256;
    }
    if (grid < 0) return;
    if (hipMemsetAsync((char*)d_ws + WS_CTL, 0, CTL_ZERO_BYTES, stream) != hipSuccess) return;
    Args a{};
    for (int i = 0; i < 12; ++i) a.in[i] = (const float*)d_in[i];
    a.out = (float*)d_out; a.ws = (unsigned char*)d_ws;
    hipLaunchKernelGGL(fwd_kernel, dim3(grid), dim3(512), LDS_BYTES, stream, a);
}
```

```cpp
#include <hip/hip_runtime.h>
#include <cstdint>
#include <cstdio>

#define GAS __attribute__((address_space(1)))
#define LAS __attribute__((address_space(3)))
typedef _Float16 f16;
typedef _Float16 f16x8 __attribute__((ext_vector_type(8)));
typedef _Float16 f16x2 __attribute__((ext_vector_type(2)));
typedef _Float16 f16x4 __attribute__((ext_vector_type(4)));
typedef float f32x2 __attribute__((ext_vector_type(2)));
typedef float f32x4 __attribute__((ext_vector_type(4)));
typedef float f32x16 __attribute__((ext_vector_type(16)));
typedef unsigned u32x4 __attribute__((ext_vector_type(4)));
typedef unsigned u32x2 __attribute__((ext_vector_type(2)));
typedef short s16x4 __attribute__((ext_vector_type(4)));
typedef short v4i16_t __attribute__((ext_vector_type(4)));
typedef int i32x8 __attribute__((ext_vector_type(8)));
typedef int i32x4 __attribute__((ext_vector_type(4)));

constexpr int BATCH = 8, SEQ = 4096, DM = 1024, M = BATCH * SEQ, DEPTH = 2;
constexpr int NIN_SRC = 5704, NIN = 5888;
constexpr int DFF = 2816, NGU = 2 * DFF;
constexpr int NH = 8, HD = 64;
constexpr int P_QKV = 1536;
constexpr int P_KI = 64;
constexpr float RMS_EPS = 1e-6f;
constexpr float LOG2E = 1.4426950408889634f;
constexpr float C2A = 0.125f * LOG2E;
constexpr float C2B = 0.125f * LOG2E;
constexpr int TOPK = 256;

constexpr size_t MiB = 1u << 20;
constexpr size_t WS_CTL = 0, CTL_ZERO_BYTES = 1 * MiB;
constexpr size_t WS_WT = 1 * MiB;
constexpr size_t WT_LAYER = 32 * MiB;
constexpr int NIN16 = 3840;
constexpr size_t WT_IN = 0, WT_G8 = WT_IN + (size_t)NIN16 * DM * 2, WT_A = WT_IN + (size_t)NIN * DM * 2, WT_B = WT_A + 1 * MiB, WT_O = WT_B + 1 * MiB, WT_GU = WT_O + 2 * MiB, WT_D = WT_GU + 11 * MiB;
static_assert(WT_D + (size_t)DM * DFF * 2 == WT_LAYER && WT_G8 + (size_t)2048 * DM <= WT_A, "weight map");
constexpr size_t WS_H = 33 * MiB;
constexpr size_t WS_QKVA = 97 * MiB;
constexpr size_t WS_QI = 193 * MiB;
constexpr size_t WS_KIW = 225 * MiB;
constexpr size_t WS_WI = WS_KIW + 4 * MiB;
constexpr size_t WS_QKVB = 233 * MiB;
constexpr size_t WS_GATES = 329 * MiB;
constexpr size_t WS_MASK = 457 * MiB;
constexpr size_t WS_H8 = 473 * MiB;
constexpr size_t WS_END = 505 * MiB;
constexpr size_t WS_HID = WS_QKVA;
static_assert(WS_HID + (size_t)M * DFF * 2 <= WS_GATES, "hid overlay");
constexpr int CW_BAR = 4096;

constexpr int RING_BYTES = 131072;
constexpr int LDS_BYTES = 147456;
constexpr int PHASE_LDS = LDS_BYTES - 256;
constexpr int MISC_OFF = PHASE_LDS;

#define RLX_AGENT __ATOMIC_RELAXED, __HIP_MEMORY_SCOPE_AGENT
#define LDS_WAIT() asm volatile("s_waitcnt lgkmcnt(0)" ::: "memory")
#define VM_WAIT() asm volatile("s_waitcnt vmcnt(0)" ::: "memory")
__device__ __forceinline__ unsigned pk2h(float lo, float hi) { f32x2 v = {lo, hi}; f16x2 h = __builtin_convertvector(v, f16x2); return __builtin_bit_cast(unsigned, h); }
template <int CTRL> __device__ __forceinline__ float dpp_mov(float x) { return __uint_as_float((unsigned)__builtin_amdgcn_update_dpp(0, (int)__float_as_uint(x), CTRL, 0xf, 0xf, false)); }
__device__ __forceinline__ float wave_sum(float v) {
    v += dpp_mov<0xB1>(v); v += dpp_mov<0x4E>(v); v += dpp_mov<0x141>(v); v += dpp_mov<0x140>(v);
    const float r0 = __uint_as_float((unsigned)__builtin_amdgcn_readlane((int)__float_as_uint(v), 0)), r1 = __uint_as_float((unsigned)__builtin_amdgcn_readlane((int)__float_as_uint(v), 16));
    const float r2 = __uint_as_float((unsigned)__builtin_amdgcn_readlane((int)__float_as_uint(v), 32)), r3 = __uint_as_float((unsigned)__builtin_amdgcn_readlane((int)__float_as_uint(v), 48));
    return (r0 + r1) + (r2 + r3);
}
__device__ __forceinline__ float sigmoidf_(float x) { return __builtin_amdgcn_rcpf(1.0f + __builtin_amdgcn_exp2f(-x * LOG2E)); }

#define XB_TMO      128
#define XB_XCNT(j)  (256  + 64 * (j))
#define XB_XSUB(j)  (1280 + 64 * (j))
#define XB_XGEN(j)  (2304 + 64 * (j))
#define XB_TOP      3328
#define XB_TOPGEN   3392
#define XCD_BAR_WORDS 3456
#define XB_SPIN_CAP (1u << 18)
__device__ __forceinline__ unsigned xb_ld(unsigned* p)              { return __hip_atomic_load(p, __ATOMIC_RELAXED, __HIP_MEMORY_SCOPE_AGENT); }
__device__ __forceinline__ unsigned xb_add(unsigned* p, unsigned v) { return __hip_atomic_fetch_add(p, v, __ATOMIC_RELAXED, __HIP_MEMORY_SCOPE_AGENT); }
__device__ __forceinline__ unsigned xb_xcc_id() { return (unsigned)__builtin_amdgcn_s_getreg((3 << 11) | 20) & 0xFu; }
#define XB_SPIN(cond, bar) do { unsigned _sp = 0; while (cond) { __builtin_amdgcn_s_sleep(1); \
    if ((++_sp & 255u) == 0u) { if (xb_ld(&(bar)[XB_TMO])) break; if (_sp > XB_SPIN_CAP) { atomicAdd(&(bar)[XB_TMO], 1u); break; } } } } while (0)
struct XcdBarrier { unsigned* bar; unsigned x; volatile LAS unsigned* st; };
__device__ __forceinline__ XcdBarrier xcd_barrier_post(unsigned* bar, volatile LAS unsigned* st) {
    XcdBarrier b; b.bar = bar; b.x = xb_xcc_id(); b.st = st;
    if (threadIdx.x == 0) (void)xb_add(&bar[XB_XCNT(b.x)], 1u);
    return b;
}
__device__ __forceinline__ void xcd_barrier_complete(unsigned* bar, unsigned x, unsigned& nloc, unsigned& nx) {
    const unsigned G = gridDim.x * gridDim.y * gridDim.z;
    unsigned sum, cnt, mine, sp = 0u;
    for (;;) {
        sum = 0u; cnt = 0u; mine = 0u;
#pragma unroll
        for (unsigned j = 0; j < 16; ++j) { const unsigned c = xb_ld(&bar[XB_XCNT(j)]); sum += c; cnt += (c > 0u) ? 1u : 0u; mine = (j == x) ? c : mine; }
        if (sum == G) break;
        __builtin_amdgcn_s_sleep(1);
        if ((++sp & 255u) == 0u) { if (xb_ld(&bar[XB_TMO])) break; if (sp > XB_SPIN_CAP) { atomicAdd(&bar[XB_TMO], 1u); break; } }
    }
    nloc = mine > 0u ? mine : 1u; nx = cnt > 0u ? cnt : 1u;
}
__device__ __forceinline__ void xcd_barrier(const XcdBarrier& b) {
    asm volatile("s_waitcnt vmcnt(0)" ::: "memory");
    __syncthreads();
    if (threadIdx.x == 0) {
        unsigned* bar = b.bar; unsigned bx = b.x; asm volatile("" : "+s"(bar), "+s"(bx));
        __builtin_amdgcn_s_waitcnt(0);
        unsigned nloc = b.st[0], nx = b.st[1];
        if (nloc == 0u) { xcd_barrier_complete(bar, bx, nloc, nx); b.st[0] = nloc; b.st[1] = nx; }
        const unsigned old = xb_add(&bar[XB_XSUB(bx)], 1u);
        const unsigned gen = old / nloc;
        if (old + 1u == (gen + 1u) * nloc) {
            __builtin_amdgcn_fence(__ATOMIC_RELEASE, "agent");
            asm volatile("s_waitcnt vmcnt(0)" ::: "memory");
            const unsigned og = xb_add(&bar[XB_TOP], 1u);
            const unsigned tg = og / nx;
            if (og + 1u == (tg + 1u) * nx) xb_add(&bar[XB_TOPGEN], 1u);
            else XB_SPIN(xb_ld(&bar[XB_TOPGEN]) == tg, bar);
            __builtin_amdgcn_fence(__ATOMIC_ACQUIRE, "agent");
            xb_add(&bar[XB_XGEN(bx)], 1u);
            asm volatile("s_waitcnt vmcnt(0)" ::: "memory");
        } else {
            XB_SPIN(xb_ld(&bar[XB_XGEN(bx)]) == gen, bar);
            __builtin_amdgcn_fence(__ATOMIC_ACQUIRE, "agent");
            asm volatile("s_waitcnt vmcnt(0)" ::: "memory");
        }
    }
    __syncthreads();
}

namespace pg8 {
constexpr int BM = 256, BK = 64, HALF = 128, HTB = HALF * BK * 2, STAGE_BYTES = 8 * HTB, NXCD = 8, WGM = 8;
__host__ __device__ __forceinline__ int lds_byte(int r, int c) { const int st = (r >> 4) * 2 + (c >> 5), rr = r & 15, cc = c & 31, ob = rr * 64 + cc * 2; return st * 1024 + (ob ^ (((ob >> 9) & 1) << 5)); }
__host__ __device__ __forceinline__ void stage_rc(int b, int& R, int& C) { const int st = b / 1024, sb = b % 1024, swz = sb ^ (((sb >> 9) & 1) << 5); R = (st >> 1) * 16 + swz / 64; C = (st & 1) * 32 + (swz % 64) / 2; }
__host__ __device__ __forceinline__ int perm32(int rho) { const int n = rho >> 4, i = rho & 15; return 8 * (i >> 2) + 4 * n + (i & 3); }
struct Unit { int pm, pn; };
struct Gemm { const f16* A; const f16* Bt; int M, N, K, lda; const f16* A2; int ksplit; };
struct StaticOrder {
    int nM, nN, nwg, G, c;
    __host__ __device__ void init(int M_, int N_, int G_, int c_) { nM = M_ / BM; nN = N_ / BM; nwg = nM * nN; G = G_; c = c_; }
    __host__ __device__ bool next(int i, Unit& u) const {
        const long L = (long)i * G + c; if (L >= nwg) return false;
        int wgid = (int)L; { const int q = nwg / NXCD, r = nwg % NXCD, xcd = wgid % NXCD, off = wgid / NXCD; wgid = (xcd < r ? xcd * (q + 1) : r * (q + 1) + (xcd - r) * q) + off; }
        const int nig = WGM * nN, gid = wgid / nig, fm = gid * WGM, gsz = (nM - fm) < WGM ? (nM - fm) : WGM;
        u.pm = fm + ((wgid % nig) % gsz); u.pn = (wgid % nig) / gsz; return true;
    }
};
struct GateOrder {
    int c;
    __host__ __device__ bool next(int i, Unit& u) const {
        const int x = c & 7, j = c >> 3; int U;
        if (j < 16) { if (i >= 3) return false; U = j + 16 * i; } else { if (i >= 5) return false; U = 48 + (j - 16) + 16 * i; }
        u.pm = 16 * x + (U >> 3); u.pn = U & 7; return true;
    }
};
template <class Epi, bool ALIGN_EPI, bool FP8, class Sched>
__device__ __forceinline__ void gemm_phase_t(LAS unsigned char* lds, const Gemm g, const Sched& S, const Epi& E) {
    int tid = threadIdx.x; asm volatile("" : "+v"(tid));
    const int wid = __builtin_amdgcn_readfirstlane(tid >> 6), lane = tid & 63, wr = wid >> 2, wc = wid & 3, fr = lane & 15, fq = lane >> 4;
    const int K = g.K, nt = K / BK, lda = g.lda;
    unsigned voffA[2], voffB[2];
#pragma unroll
    for (int i = 0; i < 2; ++i) { int R, C; stage_rc(tid * 16 + i * 8192, R, C); const int Rb = Epi::PERM ? ((R & ~31) + perm32(R & 31)) : R;
        voffA[i] = (unsigned)(R * lda + C) * 2u; voffB[i] = (unsigned)(Rb * K + C) * 2u; }
    const size_t kstep = (size_t)(BK * 2);
    const size_t hstepA = (size_t)HALF * lda * 2, hstepB = (size_t)HALF * K * 2;
    const size_t tstepA = 2 * hstepA, tstepB = 2 * hstepB;
    const int ksplit = g.A2 ? g.ksplit : 0x7fffffff;
    const long dA = g.A2 ? ((const char*)g.A2 - (const char*)g.A) - (long)g.ksplit * (long)kstep : 0;
    const unsigned ldsw = (unsigned)wid * 1024u;
    const int aoff = lds_byte(wr * 64 + fr, fq * 8), boff = lds_byte(wc * 32 + fr, fq * 8);
    const int aoff8[2] = {aoff, aoff + 1024}, boff8[2] = {boff, boff + 1024};
#define PG8_SA(b, h) (((b) * 2 + (h)) * HTB)
#define PG8_SB(b, h) ((4 + (b) * 2 + (h)) * HTB)
#define PG8_STAGE(bufoff, gbase, voff) do { _Pragma("unroll") for (int _i = 0; _i < 2; ++_i) \
        __builtin_amdgcn_global_load_lds((const unsigned*)((const char*)(gbase) + (voff)[_i]), (LAS unsigned*)(lds + (bufoff) + ldsw + _i * 8192), 16, 0, 0); } while (0)
#define PG8_LDA(dst, b, h) do { if constexpr (FP8) { _Pragma("unroll") for (int m = 0; m < 4; ++m) { const i32x4 x0 = *(const LAS i32x4*)(lds + PG8_SA(b, h) + aoff8[0] + m * 2048), x1 = *(const LAS i32x4*)(lds + PG8_SA(b, h) + aoff8[1] + m * 2048); \
            dst##8[m] = (i32x8){x0[0], x0[1], x0[2], x0[3], x1[0], x1[1], x1[2], x1[3]}; } } \
        else { _Pragma("unroll") for (int m = 0; m < 4; ++m) _Pragma("unroll") for (int k = 0; k < 2; ++k) dst[m][k] = *(const LAS f16x8*)(lds + PG8_SA(b, h) + aoff + m * 2048 + k * 1024); } } while (0)
#define PG8_LDB(dst, b, h) do { if constexpr (FP8) { _Pragma("unroll") for (int n = 0; n < 2; ++n) { const i32x4 x0 = *(const LAS i32x4*)(lds + PG8_SB(b, h) + boff8[0] + n * 2048), x1 = *(const LAS i32x4*)(lds + PG8_SB(b, h) + boff8[1] + n * 2048); \
            dst##8[n] = (i32x8){x0[0], x0[1], x0[2], x0[3], x1[0], x1[1], x1[2], x1[3]}; } } \
        else { _Pragma("unroll") for (int n = 0; n < 2; ++n) _Pragma("unroll") for (int k = 0; k < 2; ++k) dst[n][k] = *(const LAS f16x8*)(lds + PG8_SB(b, h) + boff + n * 2048 + k * 1024); } } while (0)
#define PG8_MMA(ai, bj, At, Bt) do { __builtin_amdgcn_s_setprio(1); if constexpr (FP8) { _Pragma("unroll") for (int m = 0; m < 4; ++m) _Pragma("unroll") for (int n = 0; n < 2; ++n) \
            asm volatile("v_mfma_scale_f32_16x16x128_f8f6f4 %0, %1, %2, %0, %3, %3 op_sel_hi:[0,0,0]" : "+v"(acc[ai][bj][m][n]) : "v"(Bt##8[n]), "v"(At##8[m]), "v"(scale1)); } \
        else { _Pragma("unroll") for (int m = 0; m < 4; ++m) _Pragma("unroll") for (int n = 0; n < 2; ++n) _Pragma("unroll") for (int k = 0; k < 2; ++k) \
            acc[ai][bj][m][n] = __builtin_amdgcn_mfma_f32_16x16x32_f16(Bt[n][k], At[m][k], acc[ai][bj][m][n], 0, 0, 0); } __builtin_amdgcn_s_setprio(0); } while (0)
#define PG8_WAIT_V(n) asm volatile("s_waitcnt vmcnt(" #n ")" ::: "memory")
#define PG8_WAIT_L(n) asm volatile("s_waitcnt lgkmcnt(" #n ")" ::: "memory")
#define PG8_BAR __builtin_amdgcn_s_barrier()
#define PG8_SCHED __builtin_amdgcn_sched_barrier(0)
    Unit cur, nxt; int ui = 0;
    if (!S.next(0, cur)) return;
    f32x4 acc[2][2][4][2];
#pragma unroll
    for (int a = 0; a < 2; ++a)
#pragma unroll
        for (int b = 0; b < 2; ++b)
#pragma unroll
            for (int m = 0; m < 4; ++m)
#pragma unroll
                for (int n = 0; n < 2; ++n) acc[a][b][m][n] = (f32x4){0.f, 0.f, 0.f, 0.f};
    int scale1 = 0x7f7f7f7f; asm volatile("" : "+v"(scale1));
    f16x8 At[4][2], B0[2][2], B1[2][2]; i32x8 At8[4], B08[2], B18[2]; (void)At; (void)B0; (void)B1; (void)At8; (void)B08; (void)B18;
    const char* cA = (const char*)g.A + (size_t)cur.pm * tstepA; const char* cB = (const char*)g.Bt + (size_t)cur.pn * tstepB;
    PG8_STAGE(PG8_SB(0, 0), cB, voffB); PG8_STAGE(PG8_SB(0, 1), cB + hstepB, voffB); PG8_STAGE(PG8_SA(0, 0), cA, voffA); PG8_STAGE(PG8_SA(0, 1), cA + hstepA, voffA);
    if (wr == 1) PG8_BAR;
    PG8_WAIT_V(2); PG8_BAR;
    PG8_STAGE(PG8_SB(1, 0), cB + kstep, voffB); PG8_STAGE(PG8_SA(1, 0), cA + kstep, voffA); PG8_STAGE(PG8_SB(1, 1), cB + hstepB + kstep, voffB);
    PG8_WAIT_V(6); PG8_BAR;
    for (;;) {
        const bool has_next = S.next(ui + 1, nxt);
        const char* nA = has_next ? (const char*)g.A + (size_t)nxt.pm * tstepA : cA; const char* nB = has_next ? (const char*)g.Bt + (size_t)nxt.pn * tstepB : cB;
        for (int t = 0; t < nt; t += 2) {
            const bool last = (t == nt - 2);
            const char* a1 = cA + (size_t)(t + 1) * kstep + ((t + 1 >= ksplit) ? dA : 0);
            const char* a2 = last ? nA : cA + (size_t)(t + 2) * kstep + ((t + 2 >= ksplit) ? dA : 0); const char* b2 = last ? nB : cB + (size_t)(t + 2) * kstep;
            const char* a3 = last ? nA + kstep : cA + (size_t)(t + 3) * kstep + ((t + 3 >= ksplit) ? dA : 0); const char* b3 = b2 + kstep;
            if constexpr (Epi::HAS_MID) { if (t == ksplit) E.mid(acc, cur, wr, wc, fr, fq); }
            PG8_LDB(B0, 0, 0); PG8_LDB(B1, 0, 1); PG8_SCHED; PG8_LDA(At, 0, 0); PG8_STAGE(PG8_SA(1, 1), a1 + hstepA, voffA);
            PG8_WAIT_V(8); PG8_WAIT_L(0); PG8_BAR; PG8_MMA(0, 0, At, B0); PG8_MMA(0, 1, At, B1); PG8_BAR; PG8_SCHED;
            PG8_LDA(At, 0, 1); PG8_STAGE(PG8_SB(0, 0), b2, voffB); PG8_STAGE(PG8_SB(0, 1), b2 + hstepB, voffB); PG8_STAGE(PG8_SA(0, 0), a2, voffA);
            PG8_WAIT_V(8); PG8_WAIT_L(0); PG8_BAR; PG8_MMA(1, 0, At, B0); PG8_MMA(1, 1, At, B1); PG8_BAR; PG8_SCHED;
            PG8_LDB(B0, 1, 0); PG8_LDB(B1, 1, 1); PG8_SCHED; PG8_LDA(At, 1, 0); PG8_STAGE(PG8_SA(0, 1), a2 + hstepA, voffA);
            PG8_WAIT_V(8); PG8_WAIT_L(0); PG8_BAR; PG8_MMA(0, 0, At, B0); PG8_MMA(0, 1, At, B1); PG8_BAR; PG8_SCHED;
            PG8_LDA(At, 1, 1); PG8_STAGE(PG8_SB(1, 0), b3, voffB); PG8_STAGE(PG8_SB(1, 1), b3 + hstepB, voffB); PG8_STAGE(PG8_SA(1, 0), a3, voffA);
            PG8_WAIT_V(8); PG8_WAIT_L(0); PG8_BAR; PG8_MMA(1, 0, At, B0); PG8_MMA(1, 1, At, B1); PG8_BAR; PG8_SCHED;
        }
        if constexpr (ALIGN_EPI) { if (wr == 0) PG8_BAR; }
        if constexpr (FP8) asm volatile("s_nop 15\n\ts_nop 7" ::: "memory");
        E(acc, cur, wr, wc, fr, fq);
        if (!has_next) break;
#pragma unroll
        for (int a = 0; a < 2; ++a)
#pragma unroll
            for (int b = 0; b < 2; ++b)
#pragma unroll
                for (int m = 0; m < 4; ++m)
#pragma unroll
                    for (int n = 0; n < 2; ++n) acc[a][b][m][n] = (f32x4){0.f, 0.f, 0.f, 0.f};
        cur = nxt; cA = nA; cB = nB; ++ui;
        if constexpr (ALIGN_EPI) { if (wr == 1) PG8_BAR; }
    }
    PG8_WAIT_V(0);
    if constexpr (!ALIGN_EPI) { if (wr == 0) PG8_BAR; }
    PG8_BAR;
#undef PG8_SA
#undef PG8_SB
#undef PG8_STAGE
#undef PG8_LDA
#undef PG8_LDB
#undef PG8_MMA
#undef PG8_WAIT_V
#undef PG8_WAIT_L
#undef PG8_BAR
#undef PG8_SCHED
}

template <class Epi, bool ALIGN_EPI, bool FP8 = false>
__device__ __forceinline__ void gemm_phase(LAS unsigned char* lds, const Gemm g, const StaticOrder& S, const Epi& E) { gemm_phase_t<Epi, ALIGN_EPI, FP8, StaticOrder>(lds, g, S, E); }
__device__ __forceinline__ u32x4 pack8(const f32x4& v0, const f32x4& v1) { u32x4 w; w.x = pk2h(v0[0], v0[1]); w.y = pk2h(v0[2], v0[3]); w.z = pk2h(v1[0], v1[1]); w.w = pk2h(v1[2], v1[3]); return w; }
__device__ __forceinline__ f32x4 sig4(const f32x4& v) { return (f32x4){sigmoidf_(v[0]), sigmoidf_(v[1]), sigmoidf_(v[2]), sigmoidf_(v[3])}; }
__device__ __forceinline__ void unpack8(const u32x4& w, f32x4& a, f32x4& b) {
    const f16x8 h = __builtin_bit_cast(f16x8, w);
    a = (f32x4){(float)h[0], (float)h[1], (float)h[2], (float)h[3]}; b = (f32x4){(float)h[4], (float)h[5], (float)h[6], (float)h[7]};
}
struct EpiProj {
    static constexpr bool PERM = true, HAS_MID = false;
    f16 *qkva, *qi, *kiw, *wi, *qkvb;
    __device__ __forceinline__ void operator()(const f32x4 (&acc)[2][2][4][2], const Unit& u, int wr, int wc, int fr, int fq) const {
        const int pn = u.pn; f16* base; int ldc, colt, limit = 256;
        if (pn < 6) { base = qkva; ldc = P_QKV; colt = pn * 256; }
        else if (pn < 8) { base = qi; ldc = 512; colt = (pn - 6) * 256; }
        else if (pn == 8) { base = kiw; ldc = P_KI; colt = 0; limit = 64; }
        else { base = qkvb; ldc = P_QKV; colt = (pn - 9) * 256; }
        const int row0 = u.pm * BM + wr * 64 + fr, cw = wc * 32 + 8 * fq;
#pragma unroll
        for (int ai = 0; ai < 2; ++ai)
#pragma unroll
            for (int m = 0; m < 4; ++m) { f16* rowp = base + (size_t)(row0 + ai * HALF + m * 16) * ldc + colt + cw;
                {
#pragma unroll
                for (int bj = 0; bj < 2; ++bj) if (bj * HALF + cw < limit) { f32x4 v0 = acc[ai][bj][m][0], v1 = acc[ai][bj][m][1];
                    *(u32x4*)(rowp + bj * HALF) = pack8(v0, v1); } }
                if (pn == 8 && cw == 64) *(u32x4*)(wi + (size_t)(row0 + ai * HALF + m * 16) * 8) = pack8(acc[ai][0][m][0], acc[ai][0][m][1]); }
    }
};
template <int MODE> struct EpiGate {
    static constexpr bool PERM = true, HAS_MID = false;
    f16* mo; const f16* gates;
    __device__ __forceinline__ void operator()(const f32x4 (&acc)[2][2][4][2], const Unit& u, int wr, int wc, int fr, int fq) const {
        const int row0 = u.pm * BM + wr * 64 + fr, col0 = u.pn * BM + wc * 32 + 8 * fq;
#pragma unroll
        for (int ai = 0; ai < 2; ++ai)
#pragma unroll
            for (int m = 0; m < 4; ++m) { const size_t row = (size_t)(row0 + ai * HALF + m * 16);
#pragma unroll
                for (int bj = 0; bj < 2; ++bj) { const int col = col0 + bj * HALF;
                    f32x4 g0, g1; unpack8(*(const u32x4*)(gates + row * 2048 + MODE * 1024 + col), g0, g1);
                    f32x4 v0 = acc[ai][bj][m][0] * g0, v1 = acc[ai][bj][m][1] * g1;
                    f16* op = mo + row * DM + col;
                    if (MODE == 1) { f32x4 p0, p1; unpack8(*(const u32x4*)op, p0, p1); v0 += p0; v1 += p1; }
                    *(u32x4*)op = pack8(v0, v1); } }
    }
};
constexpr float H8_SCALE = 16.0f, WG_SCALE = 64.0f;
struct EpiGates8 {
    static constexpr bool PERM = true, HAS_MID = false;
    f16* gates;
    __device__ __forceinline__ void operator()(const f32x4 (&acc)[2][2][4][2], const Unit& u, int wr, int wc, int fr, int fq) const {
        const int row0 = u.pm * BM + wr * 64 + fr, cw = wc * 32 + 8 * fq; constexpr float s = 1.0f / (H8_SCALE * WG_SCALE);
#pragma unroll
        for (int ai = 0; ai < 2; ++ai)
#pragma unroll
            for (int m = 0; m < 4; ++m) { f16* rowp = gates + (size_t)(row0 + ai * HALF + m * 16) * 2048 + u.pn * 128 + cw;
                f32x4 a0 = sig4(acc[ai][0][m][0] * s), a1 = sig4(acc[ai][0][m][1] * s), b0 = sig4(acc[ai][1][m][0] * s), b1 = sig4(acc[ai][1][m][1] * s);
#pragma unroll
                for (int e = 0; e < 4; ++e) { b0[e] = fmaxf(b0[e], 6.103515625e-5f); b1[e] = fmaxf(b1[e], 6.103515625e-5f); a0[e] *= __builtin_amdgcn_rcpf(b0[e]); a1[e] *= __builtin_amdgcn_rcpf(b1[e]); }
                *(u32x4*)rowp = pack8(a0, a1); *(u32x4*)(rowp + 1024) = pack8(b0, b1); }
    }
};
struct EpiGateMerged {
    static constexpr bool PERM = true, HAS_MID = true;
    f16* mo; const f16* gates;
    __device__ __forceinline__ void mid(f32x4 (&acc)[2][2][4][2], const Unit& u, int wr, int wc, int fr, int fq) const {
        asm volatile("" : "+v"(fr));
        const int row0 = u.pm * BM + wr * 64 + fr, col0 = u.pn * BM + wc * 32 + 8 * fq;
#pragma unroll
        for (int ai = 0; ai < 2; ++ai) {
#pragma unroll
            for (int m = 0; m < 4; ++m) { const size_t row = (size_t)(row0 + ai * HALF + m * 16);
#pragma unroll
                for (int bj = 0; bj < 2; ++bj) { f32x4 r0, r1; unpack8(*(const u32x4*)(gates + row * 2048 + col0 + bj * HALF), r0, r1); acc[ai][bj][m][0] *= r0; acc[ai][bj][m][1] *= r1; }
                if (m & 1) asm volatile("" ::: "memory"); } }
    }
    __device__ __forceinline__ void operator()(const f32x4 (&acc)[2][2][4][2], const Unit& u, int wr, int wc, int fr, int fq) const {
        const int row0 = u.pm * BM + wr * 64 + fr, col0 = u.pn * BM + wc * 32 + 8 * fq;
#pragma unroll
        for (int ai = 0; ai < 2; ++ai)
#pragma unroll
            for (int m = 0; m < 4; ++m) { const size_t row = (size_t)(row0 + ai * HALF + m * 16);
#pragma unroll
                for (int bj = 0; bj < 2; ++bj) { const int col = col0 + bj * HALF;
                    f32x4 b0, b1; unpack8(*(const u32x4*)(gates + row * 2048 + 1024 + col), b0, b1);
                    *(u32x4*)(mo + row * DM + col) = pack8(acc[ai][bj][m][0] * b0, acc[ai][bj][m][1] * b1); }
                if (m & 1) asm volatile("" ::: "memory"); }
    }
};
struct EpiF32 {
    static constexpr bool PERM = false, HAS_MID = false;
    float* C; int ldc;
    __device__ __forceinline__ void operator()(const f32x4 (&acc)[2][2][4][2], const Unit& u, int wr, int wc, int fr, int fq) const {
        const int row0 = u.pm * BM + wr * 64 + fr, col0 = u.pn * BM + wc * 32 + 4 * fq;
#pragma unroll
        for (int ai = 0; ai < 2; ++ai)
#pragma unroll
            for (int m = 0; m < 4; ++m) { float* rowp = C + (size_t)(row0 + ai * HALF + m * 16) * ldc + col0;
#pragma unroll
                for (int bj = 0; bj < 2; ++bj)
#pragma unroll
                    for (int n = 0; n < 2; ++n) *(f32x4*)(rowp + bj * HALF + n * 16) = acc[ai][bj][m][n]; }
    }
};
struct EpiF16 {
    static constexpr bool PERM = true, HAS_MID = false;
    f16* C; int ldc;
    __device__ __forceinline__ void operator()(const f32x4 (&acc)[2][2][4][2], const Unit& u, int wr, int wc, int fr, int fq) const {
        const int row0 = u.pm * BM + wr * 64 + fr, col0 = u.pn * BM + wc * 32 + 8 * fq;
#pragma unroll
        for (int ai = 0; ai < 2; ++ai)
#pragma unroll
            for (int m = 0; m < 4; ++m) { f16* rowp = C + (size_t)(row0 + ai * HALF + m * 16) * ldc + col0;
#pragma unroll
                for (int bj = 0; bj < 2; ++bj) *(u32x4*)(rowp + bj * HALF) = pack8(acc[ai][bj][m][0], acc[ai][bj][m][1]); }
    }
};
struct EpiSwiglu {
    static constexpr bool PERM = true, HAS_MID = false;
    f16* hid;
    __device__ __forceinline__ void operator()(const f32x4 (&acc)[2][2][4][2], const Unit& u, int wr, int wc, int fr, int fq) const {
        const int row0 = u.pm * BM + wr * 64 + fr, col0 = u.pn * HALF + wc * 32 + 8 * fq;
#pragma unroll
        for (int ai = 0; ai < 2; ++ai)
#pragma unroll
            for (int m = 0; m < 4; ++m) { f32x4 h[2];
#pragma unroll
                for (int n = 0; n < 2; ++n) { const f32x4 gg = acc[ai][0][m][n], uu = acc[ai][1][m][n]; h[n] = gg * sig4(gg) * uu; }
                *(u32x4*)(hid + (size_t)(row0 + ai * HALF + m * 16) * DFF + col0) = pack8(h[0], h[1]); }
    }
};
constexpr float HID_SCALE = 8.0f, WD_SCALE = 64.0f;
struct EpiSwiglu8 {
    static constexpr bool PERM = true, HAS_MID = false;
    unsigned char* hid8;
    __device__ __forceinline__ void operator()(const f32x4 (&acc)[2][2][4][2], const Unit& u, int wr, int wc, int fr, int fq) const {
        const int row0 = u.pm * BM + wr * 64 + fr, col0 = u.pn * HALF + wc * 32 + 8 * fq;
#pragma unroll
        for (int ai = 0; ai < 2; ++ai)
#pragma unroll
            for (int m = 0; m < 4; ++m) { f32x4 h[2];
#pragma unroll
                for (int n = 0; n < 2; ++n) { const f32x4 gg = acc[ai][0][m][n], uu = acc[ai][1][m][n]; h[n] = gg * sig4(gg) * uu * HID_SCALE;
#pragma unroll
                    for (int e = 0; e < 4; ++e) h[n][e] = __builtin_amdgcn_fmed3f(h[n][e], -448.f, 448.f); }
                int w0 = 0, w1 = 0;
                w0 = __builtin_amdgcn_cvt_pk_fp8_f32(h[0][0], h[0][1], w0, false); w0 = __builtin_amdgcn_cvt_pk_fp8_f32(h[0][2], h[0][3], w0, true);
                w1 = __builtin_amdgcn_cvt_pk_fp8_f32(h[1][0], h[1][1], w1, false); w1 = __builtin_amdgcn_cvt_pk_fp8_f32(h[1][2], h[1][3], w1, true);
                *(u32x2*)(hid8 + (size_t)(row0 + ai * HALF + m * 16) * DFF + col0) = (u32x2){(unsigned)w0, (unsigned)w1}; }
    }
};
struct EpiF16S {
    static constexpr bool PERM = true, HAS_MID = false;
    f16* C; int ldc; float s;
    __device__ __forceinline__ void operator()(const f32x4 (&acc)[2][2][4][2], const Unit& u, int wr, int wc, int fr, int fq) const {
        const int row0 = u.pm * BM + wr * 64 + fr, col0 = u.pn * BM + wc * 32 + 8 * fq;
#pragma unroll
        for (int ai = 0; ai < 2; ++ai)
#pragma unroll
            for (int m = 0; m < 4; ++m) { f16* rowp = C + (size_t)(row0 + ai * HALF + m * 16) * ldc + col0;
#pragma unroll
                for (int bj = 0; bj < 2; ++bj) *(u32x4*)(rowp + bj * HALF) = pack8(acc[ai][bj][m][0] * s, acc[ai][bj][m][1] * s); }
    }
};
}
struct Frame {
    LAS unsigned char* lds;
    volatile LAS unsigned* MISC;
    unsigned* ctl;
    int tid, lane, wave, vcu, G;
};

enum { MAT_IN = 0, MAT_A, MAT_B, MAT_O, MAT_GU, MAT_D, MAT_G8 };
__device__ __forceinline__ int src_col(int mat, int n, float& scale) {
    scale = 1.f;
    if (mat == MAT_IN) {
        if (n < 1536) { if (n < 512) scale = C2A; return n; }
        if (n < 2048) return n;
        if (n < 2304) { const int j = n - 2048; return j < 72 ? 2048 + j : -1; }
        if (n < 3840) { const int j = n - 2304; if (j < 512) scale = C2B; return 2120 + j; }
        { const int j = n - 3840, pg = j >> 8, jj = j & 255; return (jj < 128 ? 3656 : 4680) + pg * 128 + (jj & 127); }
    }
    if (mat == MAT_G8) { const int pg = n >> 8, jj = n & 255; return (jj < 128 ? 3656 : 4680) + pg * 128 + (jj & 127); }
    if (mat == MAT_GU) { const int pn = n >> 8, j = n & 255; return (j < 128 ? 0 : DFF) + pn * 128 + (j & 127); }
    return n;
}
__device__ __forceinline__ void transpose_item(const float* W, int K, int Nsrc, int nblk, int mat, f16* WT, LAS float* scr, int item, int lane) {
    const int kb = item / nblk, nb = item % nblk, k0 = 64 * kb, n0 = 64 * nb;
    const int n4 = (lane & 15) * 4; float scale; const int sc = src_col(mat, n0 + n4, scale);
    const float* src = W + (size_t)(k0 + (lane >> 4)) * Nsrc + (sc >= 0 ? sc : 0);
    f32x4 v[16];
#pragma unroll
    for (int i = 0; i < 16; ++i) v[i] = sc >= 0 ? *(const f32x4*)(src + (size_t)(4 * i) * Nsrc) : (f32x4){0.f, 0.f, 0.f, 0.f};
#pragma unroll
    for (int i = 0; i < 16; ++i) *(LAS f32x4*)(scr + ((lane >> 4) + 4 * i) * 68 + n4) = v[i] * scale;
    LDS_WAIT(); asm volatile("" ::: "memory");
    const int c = lane & 7;
#pragma unroll
    for (int j = 0; j < 8; ++j) { const int n = (lane >> 3) + 8 * j; const LAS float* s = scr + (8 * c) * 68 + n;
        u32x4 o; o.x = pk2h(s[0 * 68], s[1 * 68]); o.y = pk2h(s[2 * 68], s[3 * 68]); o.z = pk2h(s[4 * 68], s[5 * 68]); o.w = pk2h(s[6 * 68], s[7 * 68]);
        *(u32x4*)(WT + (size_t)(n0 + n) * K + k0 + 8 * c) = o; }
    LDS_WAIT(); asm volatile("" ::: "memory");
}
__device__ __forceinline__ void transpose_item_fp8(const float* W, int K, int Nsrc, int nblk, int mat, float wscale, f16* WT_, LAS float* scr, int item, int lane) {
    unsigned char* WT = (unsigned char*)WT_;
    const int kb = item / nblk, nb = item % nblk, k0 = 64 * kb, n0 = 64 * nb;
    const int n4 = (lane & 15) * 4; float sc_; const int sc = src_col(mat, n0 + n4, sc_);
    const float* src = W + (size_t)(k0 + (lane >> 4)) * Nsrc + sc;
    f32x4 v[16];
#pragma unroll
    for (int i = 0; i < 16; ++i) v[i] = *(const f32x4*)(src + (size_t)(4 * i) * Nsrc);
#pragma unroll
    for (int i = 0; i < 16; ++i) *(LAS f32x4*)(scr + ((lane >> 4) + 4 * i) * 68 + n4) = v[i] * wscale;
    LDS_WAIT(); asm volatile("" ::: "memory");
    const int c = lane & 7;
#pragma unroll
    for (int j = 0; j < 8; ++j) { const int n = (lane >> 3) + 8 * j; const LAS float* s = scr + (8 * c) * 68 + n;
        int w0 = 0, w1 = 0;
        w0 = __builtin_amdgcn_cvt_pk_fp8_f32(s[0 * 68], s[1 * 68], w0, false); w0 = __builtin_amdgcn_cvt_pk_fp8_f32(s[2 * 68], s[3 * 68], w0, true);
        w1 = __builtin_amdgcn_cvt_pk_fp8_f32(s[4 * 68], s[5 * 68], w1, false); w1 = __builtin_amdgcn_cvt_pk_fp8_f32(s[6 * 68], s[7 * 68], w1, true);
        *(u32x2*)(WT + (size_t)(n0 + n) * K + k0 + 8 * c) = (u32x2){(unsigned)w0, (unsigned)w1}; }
    LDS_WAIT(); asm volatile("" ::: "memory");
}
struct Inputs { const float *x, *w_in, *w_a, *w_b, *w_o, *w_gu, *w_d, *g_pre_mix, *g_post_mix, *g_pre_ffn, *g_post_ffn, *rel_bias; };

__device__ __forceinline__ void convert_weights(Frame& F0, const Inputs& I, unsigned char* ws, int l) {
    Frame F = F0; asm volatile("" : "+v"(F.lane));
    LAS float* scr = (LAS float*)(F.lds + F.wave * 17408);
    const int gw = F.vcu * 8 + F.wave, NGW = F.G * 8;
    constexpr int I_IN = (DM / 64) * (NIN16 / 64), I_G8 = (DM / 64) * (2048 / 64), I_A = (512 / 64) * (DM / 64), I_O = (DM / 64) * (DM / 64), I_GU = (DM / 64) * (NGU / 64), I_D = (DFF / 64) * (DM / 64);
    constexpr int PER_LAYER = I_IN + I_G8 + 2 * I_A + I_O + I_GU + I_D;
    unsigned char* wt = ws + WS_WT;
    for (int it = gw; it < PER_LAYER; it += NGW) {
        int r = it;
        if (r < I_IN) { transpose_item(I.w_in + (size_t)l * DM * NIN_SRC, DM, NIN_SRC, NIN16 / 64, MAT_IN, (f16*)(wt + WT_IN), scr, r, F.lane); continue; } r -= I_IN;
        if (r < I_G8) { transpose_item_fp8(I.w_in + (size_t)l * DM * NIN_SRC, DM, NIN_SRC, 2048 / 64, MAT_G8, pg8::WG_SCALE, (f16*)(wt + WT_G8), scr, r, F.lane); continue; } r -= I_G8;
        if (r < I_A) { transpose_item(I.w_a + (size_t)l * 512 * DM, DM, DM, DM / 64, MAT_A, (f16*)(wt + WT_A), scr, r, F.lane); continue; } r -= I_A;
        if (r < I_A) { transpose_item(I.w_b + (size_t)l * 512 * DM, DM, DM, DM / 64, MAT_B, (f16*)(wt + WT_A) + 512, scr, r, F.lane); continue; } r -= I_A;
        if (r < I_O) { transpose_item(I.w_o + (size_t)l * DM * DM, DM, DM, DM / 64, MAT_O, (f16*)(wt + WT_O), scr, r, F.lane); continue; } r -= I_O;
        if (r < I_GU) { transpose_item(I.w_gu + (size_t)l * DM * NGU, DM, NGU, NGU / 64, MAT_GU, (f16*)(wt + WT_GU), scr, r, F.lane); continue; } r -= I_GU;
        transpose_item_fp8(I.w_d + (size_t)l * DFF * DM, DFF, DM, DM / 64, MAT_D, pg8::WD_SCALE, (f16*)(wt + WT_D), scr, r, F.lane);
    }
}

__device__ __forceinline__ float sat8(float v) { return __builtin_amdgcn_fmed3f(v, -448.f, 448.f); }
__device__ __forceinline__ unsigned pk4f8(const f32x4& t, float s) { int w = 0; w = __builtin_amdgcn_cvt_pk_fp8_f32(sat8(t.x * s), sat8(t.y * s), w, false); w = __builtin_amdgcn_cvt_pk_fp8_f32(sat8(t.z * s), sat8(t.w * s), w, true); return (unsigned)w; }
__device__ __forceinline__ void norm_to_f16(Frame& F0, const float* x, const float* g, f16* h, unsigned char* h8) {
    Frame F = F0; asm volatile("" : "+v"(F.lane));
    const int gw = F.vcu * 8 + F.wave, NGW = F.G * 8;
    f32x4 gv[4];
#pragma unroll
    for (int j = 0; j < 4; ++j) gv[j] = ((const f32x4*)g)[F.lane + 64 * j];
    f32x4 ra[4], rb[4], rc[4], rd[4];
#pragma unroll
    for (int j = 0; j < 4; ++j) ra[j] = ((const GAS f32x4*)(x + (size_t)gw * DM) + F.lane)[64 * j];
#pragma unroll
    for (int j = 0; j < 4; ++j) rb[j] = ((const GAS f32x4*)(x + (size_t)(gw + NGW) * DM) + F.lane)[64 * j];
#pragma unroll
    for (int j = 0; j < 4; ++j) rc[j] = ((const GAS f32x4*)(x + (size_t)(gw + 2 * NGW) * DM) + F.lane)[64 * j];
#pragma unroll
    for (int j = 0; j < 4; ++j) rd[j] = ((const GAS f32x4*)(x + (size_t)(gw + 3 * NGW) * DM) + F.lane)[64 * j];
    __builtin_amdgcn_s_waitcnt(0x0F70);
    auto row = [&](int m, f32x4 (&r)[4]) {
        f32x4 v[4]; float s = 0.f;
#pragma unroll
        for (int j = 0; j < 4; ++j) v[j] = r[j];
        { const int mn = (m + 4 * NGW < M) ? m + 4 * NGW : m; const GAS f32x4* xr = (const GAS f32x4*)(x + (size_t)mn * DM) + F.lane;
#pragma unroll
          for (int j = 0; j < 4; ++j) r[j] = xr[64 * j]; }
        asm volatile("" ::: "memory");
#pragma unroll
        for (int j = 0; j < 4; ++j) s += (v[j].x * v[j].x + v[j].y * v[j].y) + (v[j].z * v[j].z + v[j].w * v[j].w);
        const float rstd = 1.0f / sqrtf(wave_sum(s) * (1.f / DM) + RMS_EPS);
        GAS u32x2* o = (GAS u32x2*)(h + (size_t)m * DM) + F.lane;
#pragma unroll
        for (int j = 0; j < 4; ++j) { const f32x4 t = v[j] * rstd * gv[j]; o[64 * j] = (u32x2){pk2h(t.x, t.y), pk2h(t.z, t.w)}; ((GAS unsigned*)(h8 + (size_t)m * DM))[F.lane + 64 * j] = pk4f8(t, pg8::H8_SCALE); }
    };
    for (int m = gw; m < M; m += 4 * NGW) { row(m, ra); row(m + NGW, rb); row(m + 2 * NGW, rc); row(m + 3 * NGW, rd); }
}
template <bool XI16> struct XRaw;
template <> struct XRaw<true> { f16x4 r[4]; __device__ __forceinline__ void load(const void* p, size_t m, int lane) { _Pragma("unroll") for (int j = 0; j < 4; ++j) r[j] = ((const GAS f16x4*)((const f16*)p + m * DM) + lane)[64 * j]; }
    __device__ __forceinline__ f32x4 get(int j) const { return (f32x4){(float)r[j][0], (float)r[j][1], (float)r[j][2], (float)r[j][3]}; } };
template <> struct XRaw<false> { f32x4 r[4]; __device__ __forceinline__ void load(const void* p, size_t m, int lane) { _Pragma("unroll") for (int j = 0; j < 4; ++j) r[j] = ((const GAS f32x4*)((const float*)p + m * DM) + lane)[64 * j]; }
    __device__ __forceinline__ f32x4 get(int j) const { return r[j]; } };
template <bool XI16, bool XO16> __device__ __forceinline__ void norm_residual(Frame& F0, const void* xi_, const f16* y, const float* g1, void* xo_, const float* g2, f16* h, unsigned char* h8) {
    Frame F = F0; asm volatile("" : "+v"(F.lane));
    const int gw = F.vcu * 8 + F.wave, NGW = F.G * 8;
    f32x4 gv1[4], gv2[4];
#pragma unroll
    for (int j = 0; j < 4; ++j) { gv1[j] = ((const f32x4*)g1)[F.lane + 64 * j]; gv2[j] = h ? ((const f32x4*)g2)[F.lane + 64 * j] : (f32x4){0.f, 0.f, 0.f, 0.f}; }
    XRaw<true> ya, yb, yc, yd; XRaw<XI16> xa, xb, xc, xd;
    ya.load(y, (size_t)gw, F.lane); xa.load(xi_, (size_t)gw, F.lane); yb.load(y, (size_t)(gw + NGW), F.lane); xb.load(xi_, (size_t)(gw + NGW), F.lane);
    yc.load(y, (size_t)(gw + 2 * NGW), F.lane); xc.load(xi_, (size_t)(gw + 2 * NGW), F.lane); yd.load(y, (size_t)(gw + 3 * NGW), F.lane); xd.load(xi_, (size_t)(gw + 3 * NGW), F.lane);
    __builtin_amdgcn_s_waitcnt(0x0F70);
    auto row = [&](int m, XRaw<true>& ry, XRaw<XI16>& rx) {
        f32x4 v[4], xv[4]; float s = 0.f;
#pragma unroll
        for (int j = 0; j < 4; ++j) { v[j] = ry.get(j); xv[j] = rx.get(j); }
        { const int mn = (m + 4 * NGW < M) ? m + 4 * NGW : m; ry.load(y, (size_t)mn, F.lane); rx.load(xi_, (size_t)mn, F.lane); }
        asm volatile("" ::: "memory");
#pragma unroll
        for (int j = 0; j < 4; ++j) s += (v[j].x * v[j].x + v[j].y * v[j].y) + (v[j].z * v[j].z + v[j].w * v[j].w);
        const float rstd = 1.0f / sqrtf(wave_sum(s) * (1.f / DM) + RMS_EPS);
        float s2 = 0.f;
#pragma unroll
        for (int j = 0; j < 4; ++j) { xv[j] = xv[j] + v[j] * rstd * gv1[j];
            if (XO16) ((GAS u32x2*)((f16*)xo_ + (size_t)m * DM) + F.lane)[64 * j] = (u32x2){pk2h(xv[j].x, xv[j].y), pk2h(xv[j].z, xv[j].w)};
            else ((GAS f32x4*)((float*)xo_ + (size_t)m * DM) + F.lane)[64 * j] = xv[j];
            s2 += (xv[j].x * xv[j].x + xv[j].y * xv[j].y) + (xv[j].z * xv[j].z + xv[j].w * xv[j].w); }
        if (h) {
            const float rstd2 = 1.0f / sqrtf(wave_sum(s2) * (1.f / DM) + RMS_EPS);
            GAS u32x2* o = (GAS u32x2*)(h + (size_t)m * DM) + F.lane;
#pragma unroll
            for (int j = 0; j < 4; ++j) { const f32x4 t = xv[j] * rstd2 * gv2[j]; o[64 * j] = (u32x2){pk2h(t.x, t.y), pk2h(t.z, t.w)}; if (h8) ((GAS unsigned*)(h8 + (size_t)m * DM))[F.lane + 64 * j] = pk4f8(t, pg8::H8_SCALE); }
        }
    };
    for (int m = gw; m < M; m += 4 * NGW) { row(m, ya, xa); row(m + NGW, yb, xb); row(m + 2 * NGW, yc, xc); row(m + 3 * NGW, yd, xd); }
}
#define MFMA32(a, b, c) __builtin_amdgcn_mfma_f32_32x32x16_f16(a, b, c, 0, 0, 0)
#define WAIT_BAR0() asm volatile("s_waitcnt vmcnt(0) lgkmcnt(0)\n\ts_barrier" ::: "memory")
typedef LAS const unsigned char* lds_cptr;
__device__ __forceinline__ int crow(int r, int hi) { return (r & 3) + 8 * (r >> 2) + 4 * hi; }
__device__ __forceinline__ void glds16(const void* g, unsigned lds_base) {
    unsigned sv; asm volatile("s_mov_b32 %0, m0\n\ts_mov_b32 m0, %2\n\ts_nop 0\n\tglobal_load_lds_dwordx4 %1, off\n\ts_mov_b32 m0, %0" : "=&s"(sv) : "v"(g), "s"(lds_base) : "memory"); }
__device__ __forceinline__ void glds16s(unsigned voff, const void* sbase, unsigned lds_base) {
    unsigned sv; asm volatile("s_mov_b32 %0, m0\n\ts_mov_b32 m0, %3\n\ts_nop 0\n\tglobal_load_lds_dwordx4 %1, %2\n\ts_mov_b32 m0, %0" : "=&s"(sv) : "v"(voff), "s"(sbase), "s"(lds_base) : "memory"); }
__device__ __forceinline__ s16x4 vtr(lds_cptr p) { return __builtin_bit_cast(s16x4, __builtin_amdgcn_ds_read_tr16_b64_v4i16((LAS v4i16_t*)p)); }
__device__ __forceinline__ float rowmax32(const f32x16& p0, const f32x16& p1) {
    float a = fmaxf(fmaxf(p0[0], p0[1]), p1[0]), b = fmaxf(fmaxf(p0[2], p0[3]), p1[1]); a = fmaxf(fmaxf(a, p1[2]), p1[3]);
#pragma unroll
    for (int r = 4; r < 16; r += 4) { a = fmaxf(fmaxf(a, p0[r]), p0[r + 1]); b = fmaxf(fmaxf(b, p0[r + 2]), p0[r + 3]); a = fmaxf(fmaxf(a, p1[r]), p1[r + 1]); b = fmaxf(fmaxf(b, p1[r + 2]), p1[r + 3]); }
    const float m = fmaxf(a, b); auto rr = __builtin_amdgcn_permlane32_swap(__float_as_uint(m), __float_as_uint(m), false, false);
    return fmaxf(__uint_as_float(rr[0]), __uint_as_float(rr[1]));
}
__device__ __forceinline__ void qk_tile(f32x16& p0, f32x16& p1, lds_cptr kp, const f16x8 (&qr)[4]) {
    p0 = f32x16{}; p1 = f32x16{};
#pragma unroll
    for (int d0 = 0; d0 < 4; ++d0) { const f16x8 k0 = *(const LAS f16x8*)(kp + d0 * 2048), k1 = *(const LAS f16x8*)(kp + d0 * 2048 + 512);
        p0 = MFMA32(k0, qr[d0], p0); p1 = MFMA32(k1, qr[d0], p1); }
}
__device__ __forceinline__ void pv_tile(f32x16 (&o)[2], lds_cptr vp, const u32x4 (&pw)[4]) {
#pragma unroll
    for (int dh = 0; dh < 2; ++dh)
#pragma unroll
        for (int ks = 0; ks < 4; ++ks) { const s16x4 lo = vtr(vp + dh * 4096 + ks * 1024), hi = vtr(vp + dh * 4096 + ks * 1024 + 512);
            const s16x4 z[2] = {lo, hi}; const f16x8 vf = __builtin_bit_cast(f16x8, z);
            o[dh] = MFMA32(__builtin_bit_cast(f16x8, pw[ks]), vf, o[dh]); }
}
__device__ __forceinline__ void store_o(const f32x16 (&o)[2], const float (&rs)[16], LAS f16* stg, f16* Ow, int pitch, int lane) {
    const int r32 = lane & 31, hi = lane >> 5;
#pragma unroll
    for (int r = 0; r < 16; ++r) { const int orow = crow(r, hi);
#pragma unroll
        for (int d0 = 0; d0 < 2; ++d0) stg[orow * 64 + d0 * 32 + r32] = (f16)(o[d0][r] * rs[r]); }
    LDS_WAIT(); asm volatile("" ::: "memory");
#pragma unroll
    for (int i = 0; i < 4; ++i) { const int row = i * 8 + (lane >> 3), ch = lane & 7; *(u32x4*)(Ow + (size_t)row * pitch + ch * 8) = *(const LAS u32x4*)(stg + row * 64 + ch * 8); }
}
constexpr int AT_LK = 0, AT_LV = 16384, AT_LTB = 32768, AT_LWS = 33792, AT_LOST = 35840, AT_LDS = AT_LOST + 8 * 4096;

__device__ __forceinline__ void sbattn_unit(int b, int h, int qb, const f16* QKV, f16* Odst, int opitch, LAS unsigned char* shm) {
    int tid = threadIdx.x; asm volatile("" : "+v"(tid)); const int lane = tid & 63, r32 = lane & 31, hi = lane >> 5; const int wid = __builtin_amdgcn_readfirstlane(tid >> 6);
    const size_t rowbase = (size_t)b * SEQ; const int Q0 = qb * 256, w0 = Q0 + wid * 32, jmax = 4 * qb + 3;
    const f16* Qw = QKV + (rowbase + w0) * P_QKV + h * 64;
    const f16* ksrc = QKV + (rowbase + lane) * P_QKV + 512 + h * 64 + wid * 8;
    const f16* vsrc = QKV + (rowbase + 16 * (wid & 3) + (lane >> 2)) * P_QKV + 1024 + h * 64 + (wid >> 2) * 32 + (lane & 3) * 8;
    const unsigned lds0 = (unsigned)(uintptr_t)shm;
    const unsigned kdst = lds0 + AT_LK + wid * 1024, vdst = lds0 + AT_LV + wid * 1024;
#define SB_DMA(t, slot) do { glds16(ksrc + (size_t)(t) * 64 * P_QKV, (unsigned)__builtin_amdgcn_readfirstlane(kdst + (slot) * 8192)); \
                             glds16(vsrc + (size_t)(t) * 64 * P_QKV, (unsigned)__builtin_amdgcn_readfirstlane(vdst + (slot) * 8192)); } while (0)
    LAS unsigned* flags = (LAS unsigned*)(shm + AT_LWS);
    SB_DMA(jmax, 0);
    f16x8 qr[4];
#pragma unroll
    for (int d0 = 0; d0 < 4; ++d0) qr[d0] = *(const f16x8*)(Qw + (size_t)r32 * P_QKV + d0 * 16 + hi * 8);
    float carry = 1.0f; f32x16 o[2]; o[0] = f32x16{}; o[1] = f32x16{};
    const lds_cptr kp0 = (lds_cptr)shm + AT_LK + hi * 1024 + r32 * 16;
    const lds_cptr vp0 = (lds_cptr)shm + AT_LV + ((lane >> 4) & 1) * 32 + (lane & 3) * 8 + (4 * hi + ((lane & 15) >> 2)) * 64;
    WAIT_BAR0();
    int it = 0; bool live = true;
    for (int t = jmax; t >= 0; --t, ++it) {
        const int slot = it & 1;
        if (t > 0) SB_DMA(t - 1, slot ^ 1);
        if (64 * t < w0 + 31 && live) {
            f32x16 k0, k1; qk_tile(k0, k1, kp0 + slot * 8192, qr);
            f32x16 b0, b1;
            const bool band = (64 * t + 63 >= w0); const int kb0 = 64 * t + 4 * hi - (w0 + r32);
#pragma unroll
            for (int r = 0; r < 16; ++r) { const int kc = (r & 3) + 8 * (r >> 2);
                const float E0 = __builtin_amdgcn_exp2f(k0[r]), E1 = __builtin_amdgcn_exp2f(k1[r]);
                float kk0 = __builtin_amdgcn_rcpf(1.0f + E0), kk1 = __builtin_amdgcn_rcpf(1.0f + E1); float bb0 = 1.0f - kk0, bb1 = 1.0f - kk1;
                if (band) { if (kb0 + kc >= 0) { kk0 = 1.f; bb0 = 0.f; } if (kb0 + kc + 32 >= 0) { kk1 = 1.f; bb1 = 0.f; } }
                k0[r] = kk0; k1[r] = kk1; b0[r] = bb0; b1[r] = bb1; }
            float gp[8];
#pragma unroll
            for (int j = 0; j < 4; ++j) {
                { const float s2 = k0[4 * j + 3], s1 = s2 * k0[4 * j + 2], s0 = s1 * k0[4 * j + 1]; gp[j] = s0 * k0[4 * j]; b0[4 * j + 2] *= s2; b0[4 * j + 1] *= s1; b0[4 * j] *= s0; }
                { const float s2 = k1[4 * j + 3], s1 = s2 * k1[4 * j + 2], s0 = s1 * k1[4 * j + 1]; gp[4 + j] = s0 * k1[4 * j]; b1[4 * j + 2] *= s2; b1[4 * j + 1] *= s1; b1[4 * j] *= s0; }
            }
            float base[8]; float sp = carry;
#pragma unroll
            for (int g = 7; g >= 0; --g) { const unsigned own = __float_as_uint(gp[g]); auto rr = __builtin_amdgcn_permlane32_swap(own, own, false, false);
                base[g] = sp * (hi ? 1.0f : __uint_as_float(rr[1])); sp *= __uint_as_float(rr[0]) * __uint_as_float(rr[1]); }
            carry = sp;
#pragma unroll
            for (int j = 0; j < 4; ++j)
#pragma unroll
                for (int i = 0; i < 4; ++i) { b0[4 * j + i] *= base[j]; b1[4 * j + i] *= base[4 + j]; }
            u32x4 pw[4];
#pragma unroll
            for (int k = 0; k < 4; ++k) { pw[0][k] = pk2h(b0[2 * k], b0[2 * k + 1]); pw[1][k] = pk2h(b0[8 + 2 * k], b0[9 + 2 * k]); pw[2][k] = pk2h(b1[2 * k], b1[2 * k + 1]); pw[3][k] = pk2h(b1[8 + 2 * k], b1[9 + 2 * k]); }
            pv_tile(o, vp0 + slot * 8192, pw);
            live = __any(carry != 0.0f);
        }
        const bool alive = (t > 0) && live;
        if (lane == 0) flags[(it & 1) * 8 + wid] = alive ? 1u : 0u;
        WAIT_BAR0();
        unsigned any = 0;
#pragma unroll
        for (int w = 0; w < 8; ++w) any |= flags[(it & 1) * 8 + w];
        if (!any) break;
    }
    float ones[16];
#pragma unroll
    for (int r = 0; r < 16; ++r) ones[r] = 1.0f;
    store_o(o, ones, (LAS f16*)(shm + AT_LOST) + wid * 2048, Odst + (rowbase + w0) * opitch + h * 64, opitch, lane);
    WAIT_BAR0();
#undef SB_DMA
}

constexpr int IX_NB = 1024;
constexpr int IX_NSLOT = 3;
constexpr int IX_HIST = 0;
constexpr int IX_RING = 32768;
constexpr int IX_BIG = IX_HIST;
constexpr int IX_MM = IX_RING + 8 * IX_NSLOT * 4096;
constexpr int IX_INFO = IX_MM + 512;
constexpr int IX_OVF = IX_INFO + 256;
constexpr int IX_CAND = IX_OVF + 16;
constexpr int IX_MB = IX_CAND + 4096;
constexpr int IX_LDS = IX_MB + 4096;
static_assert(IX_LDS <= PHASE_LDS, "indexer LDS");
#define IX_BAR() asm volatile("s_waitcnt lgkmcnt(0)\n\ts_barrier" ::: "memory")
__device__ __forceinline__ unsigned f2ord(float f) { const unsigned u = __float_as_uint(f); return u ^ ((unsigned)((int)u >> 31) | 0x80000000u); }
__device__ __forceinline__ float ord2f(unsigned k) { return __uint_as_float(k ^ ((k >> 31) ? 0x80000000u : 0xFFFFFFFFu)); }
template <int CTRL, int ROWMASK> __device__ __forceinline__ unsigned dpp_z(unsigned x) { return (unsigned)__builtin_amdgcn_update_dpp(0, (int)x, CTRL, ROWMASK, 0xf, false); }
template <int CTRL> __device__ __forceinline__ float dpp_f(float x) { return __uint_as_float((unsigned)__builtin_amdgcn_update_dpp((int)__float_as_uint(x), (int)__float_as_uint(x), CTRL, 0xf, 0xf, false)); }
#define LDS_ADD(p, v) __hip_atomic_fetch_add((p), (v), __ATOMIC_RELAXED, __HIP_MEMORY_SCOPE_WORKGROUP)

__device__ __forceinline__ void indexer_front(int b, int tau, const f16* QI, const f16* KI, const f16* WI, LAS unsigned char* shm, f16x8 (&aq)[2][4], f16x8 (&wraw)[2][2]) {
    int tid = threadIdx.x; asm volatile("" : "+v"(tid)); const int lane = tid & 63, r32 = lane & 31, hi = lane >> 5; const int wid = __builtin_amdgcn_readfirstlane(tid >> 6);
    const int t0 = tau * 8, c = tau >> 3, NKB = 2 * (c + 1); const size_t rowg = (size_t)b * SEQ;
    const int j_ = r32 >> 3, hp = (r32 >> 2) & 1, i_ = r32 & 3, head = 4 * (j_ & 1) + i_, qq = 2 * (j_ >> 1) + hp;
#pragma unroll
    for (int rb = 0; rb < 2; ++rb)
#pragma unroll
        for (int ks = 0; ks < 4; ++ks) aq[rb][ks] = *(const f16x8*)(QI + (rowg + t0 + 4 * rb + qq) * 512 + head * 64 + 16 * ks + 8 * hi);
#pragma unroll
    for (int rb = 0; rb < 2; ++rb)
#pragma unroll
        for (int u = 0; u < 2; ++u) wraw[rb][u] = *(const f16x8*)(WI + (rowg + t0 + 4 * rb + hi + 2 * u) * 8);
    const int nkb_w = (NKB - wid + 7) >> 3;
    const unsigned ring0 = (unsigned)__builtin_amdgcn_readfirstlane((unsigned)(uintptr_t)shm + IX_RING + wid * (IX_NSLOT * 4096));
    const unsigned voff_e = (unsigned)(((lane >> 3) * P_KI + (((lane & 7) ^ (lane >> 4)) * 8)) * 2);
    const unsigned voff_o = (unsigned)(((lane >> 3) * P_KI + (((lane & 7) ^ (4 + (lane >> 4))) * 8)) * 2);
    const f16* kwave = KI + (rowg + (size_t)wid * 32) * P_KI;
#pragma unroll
    for (int st = 0; st < 2; ++st) if (st < nkb_w) { const f16* sb_ = kwave + (size_t)st * 256 * P_KI; const unsigned d_ = ring0 + st * 4096;
        glds16s(voff_e, sb_, d_); glds16s(voff_o, sb_ + 8 * P_KI, d_ + 1024); glds16s(voff_e, sb_ + 16 * P_KI, d_ + 2048); glds16s(voff_o, sb_ + 24 * P_KI, d_ + 3072); }
}
__device__ __forceinline__ void indexer_unit(int b, int tau, const f16* QI, const f16* KI, const f16* WI, unsigned* maskR, LAS unsigned char* shm, f16x8 (&aq)[2][4], f16x8 (&wraw)[2][2], bool has_next, int b_next, int tau_next) {
    int tid = threadIdx.x; asm volatile("" : "+v"(tid)); const int lane = tid & 63, r32 = lane & 31, hi = lane >> 5; const int wid = __builtin_amdgcn_readfirstlane(tid >> 6);
    const int t0 = tau * 8, c = tau >> 3, NKB = 2 * (c + 1), N = 64 * (c + 1);
    const size_t rowg = (size_t)b * SEQ;
    LAS unsigned* hist = (LAS unsigned*)(shm + IX_HIST);
    LAS unsigned* mmx = (LAS unsigned*)(shm + IX_MM);
    LAS unsigned* info = (LAS unsigned*)(shm + IX_INFO);
    LAS unsigned* ovf = (LAS unsigned*)(shm + IX_OVF);
    LAS u32x2* cand = (LAS u32x2*)(shm + IX_CAND);
    LAS unsigned* mb = (LAS unsigned*)(shm + IX_MB);
    LAS u32x2* big = (LAS u32x2*)(shm + IX_BIG);
    if (N > TOPK) {
#pragma unroll
        for (int j = 0; j < 4; ++j) *(LAS u32x4*)(shm + IX_HIST + (j * 512 + tid) * 16) = (u32x4){0u, 0u, 0u, 0u};
    }
    if (tid < 68) info[tid] = 0u;
    if (tid < 16) mmx[tid] = 0u;
    mb[tid] = 0u; mb[tid + 512] = 0u;
    float sf[2][16][2];
    const int nkb_w = (NKB - wid + 7) >> 3;
    const unsigned ring0 = (unsigned)__builtin_amdgcn_readfirstlane((unsigned)(uintptr_t)shm + IX_RING + wid * (IX_NSLOT * 4096));
    const unsigned voff_e = (unsigned)(((lane >> 3) * P_KI + (((lane & 7) ^ (lane >> 4)) * 8)) * 2);
    const unsigned voff_o = (unsigned)(((lane >> 3) * P_KI + (((lane & 7) ^ (4 + (lane >> 4))) * 8)) * 2);
    const f16* kwave = KI + (rowg + (size_t)wid * 32) * P_KI;
#define IX_DMA(step, slot) do { const f16* sb_ = kwave + (size_t)(step) * 256 * P_KI; const unsigned d_ = ring0 + (slot) * 4096; \
        glds16s(voff_e, sb_, d_); glds16s(voff_o, sb_ + 8 * P_KI, d_ + 1024); glds16s(voff_e, sb_ + 16 * P_KI, d_ + 2048); glds16s(voff_o, sb_ + 24 * P_KI, d_ + 3072); } while (0)
    const lds_cptr rrd = (lds_cptr)shm + IX_RING + wid * (IX_NSLOT * 4096) + r32 * 128;
    const int rsw = (r32 >> 1) & 7;
    f32x16 dd[2][2];
#define IX_FRAG_MFMA(step, dst) do { f16x8 bk[4]; _Pragma("unroll") for (int ks = 0; ks < 4; ++ks) bk[ks] = *(const LAS f16x8*)(rrd + ((step) % IX_NSLOT) * 4096 + (((2 * ks + hi) ^ rsw) * 16)); \
        _Pragma("unroll") for (int rb = 0; rb < 2; ++rb) { f32x16 d = f32x16{}; _Pragma("unroll") for (int ks = 0; ks < 4; ++ks) d = MFMA32(aq[rb][ks], bk[ks], d); dst[rb] = d; } } while (0)
    if (0 < nkb_w) { if (1 < nkb_w) asm volatile("s_waitcnt vmcnt(4)" ::: "memory"); else asm volatile("s_waitcnt vmcnt(0)" ::: "memory"); IX_FRAG_MFMA(0, dd[0]); }
    float wq[2][2][8];
#pragma unroll
    for (int rb = 0; rb < 2; ++rb)
#pragma unroll
        for (int u = 0; u < 2; ++u)
#pragma unroll
            for (int hh = 0; hh < 8; ++hh) wq[rb][u][hh] = (float)wraw[rb][u][hh];
#pragma unroll
    for (int i = 0; i < 16; ++i) {
        if (i < nkb_w) {
            if (i + 2 < nkb_w) { asm volatile("s_waitcnt lgkmcnt(0)" ::: "memory"); IX_DMA(i + 2, (i + 2) % IX_NSLOT); }
            if (i + 1 < nkb_w) { if (i + 2 < nkb_w) asm volatile("s_waitcnt vmcnt(4)" ::: "memory"); else asm volatile("s_waitcnt vmcnt(0)" ::: "memory");
                IX_FRAG_MFMA(i + 1, dd[(i + 1) & 1]); }
#pragma unroll
            for (int rb = 0; rb < 2; ++rb)
#pragma unroll
                for (int u = 0; u < 2; ++u) { float s = 0.f;
#pragma unroll
                    for (int hh = 0; hh < 8; ++hh) { const int xb_ = (int)__float_as_uint(dd[i & 1][rb][8 * u + hh]); s = __builtin_fmaf(__uint_as_float((unsigned)(xb_ > 0 ? xb_ : 0)), wq[rb][u][hh], s); }
                    sf[rb][i][u] = s; }
        } else { sf[0][i][0] = 0.f; sf[0][i][1] = 0.f; sf[1][i][0] = 0.f; sf[1][i][1] = 0.f; }
    }
    asm volatile("s_waitcnt lgkmcnt(0)" ::: "memory");
#undef IX_FRAG_MFMA
    if (has_next) indexer_front(b_next, tau_next, QI, KI, WI, shm, aq, wraw);
#undef IX_DMA
    float T[4] = {0.f, 0.f, 0.f, 0.f}; unsigned It[4] = {4095u, 4095u, 4095u, 4095u}; bool dup = false;
    if (N > TOPK) {
        float scale[4], c0[4];
        { float mn[4], mx[4];
#pragma unroll
            for (int s = 0; s < 4; ++s) { float a = sf[s >> 1][0][s & 1], z = a;
#pragma unroll
                for (int i = 1; i < 16; ++i) if (wid + 8 * i < NKB) { a = fminf(a, sf[s >> 1][i][s & 1]); z = fmaxf(z, sf[s >> 1][i][s & 1]); }
                a = fminf(a, dpp_f<0xB1>(a)); z = fmaxf(z, dpp_f<0xB1>(z));
                a = fminf(a, dpp_f<0x4E>(a)); z = fmaxf(z, dpp_f<0x4E>(z));
                a = fminf(a, dpp_f<0x141>(a)); z = fmaxf(z, dpp_f<0x141>(z));
                a = fminf(a, dpp_f<0x140>(a)); z = fmaxf(z, dpp_f<0x140>(z));
                a = fminf(a, dpp_f<0x142>(a)); z = fmaxf(z, dpp_f<0x142>(z));
                mn[s] = a; mx[s] = z; }
            if (r32 == 31) {
#pragma unroll
                for (int s = 0; s < 4; ++s) { __hip_atomic_fetch_max(&mmx[(2 * s + hi) * 2 + 0], f2ord(mx[s]), __ATOMIC_RELAXED, __HIP_MEMORY_SCOPE_WORKGROUP);
                                              __hip_atomic_fetch_max(&mmx[(2 * s + hi) * 2 + 1], f2ord(-mn[s]), __ATOMIC_RELAXED, __HIP_MEMORY_SCOPE_WORKGROUP); } }
            IX_BAR();
#pragma unroll
            for (int s = 0; s < 4; ++s) { const u32x2 w_ = *(const LAS u32x2*)(mmx + (2 * s + hi) * 2); const float z = ord2f(w_.x), a = -ord2f(w_.y);
                scale[s] = (z > a) ? (float)(IX_NB - 1) / (z - a) : 0.f; c0[s] = -a * scale[s]; } }
        { unsigned hb[4];
#pragma unroll
            for (int s = 0; s < 4; ++s) hb[s] = (unsigned)(uintptr_t)shm + IX_HIST + (2 * s + hi) * (IX_NB * 4);
#pragma unroll
            for (int i = 0; i < 16; ++i) if (wid + 8 * i < NKB) {
#pragma unroll
                for (int s = 0; s < 4; ++s) { int bin = (int)__builtin_fmaf(sf[s >> 1][i][s & 1], scale[s], c0[s]); bin = bin > IX_NB - 1 ? IX_NB - 1 : bin;
                    LDS_ADD((LAS unsigned*)(uintptr_t)(hb[s] + 4u * (unsigned)bin), 1u); } } }
        IX_BAR();
        { const int q = wid, lb = 16 * (63 - lane); unsigned h[16]; unsigned tot = 0u;
#pragma unroll
            for (int k4 = 0; k4 < 4; ++k4) { const u32x4 w_ = *(const LAS u32x4*)(shm + IX_HIST + (q * IX_NB + lb + 4 * k4) * 4);
                h[4 * k4] = w_.x; h[4 * k4 + 1] = w_.y; h[4 * k4 + 2] = w_.z; h[4 * k4 + 3] = w_.w; tot += (w_.x + w_.y) + (w_.z + w_.w); }
            unsigned x = tot;
            x += dpp_z<0x111, 0xf>(x); x += dpp_z<0x112, 0xf>(x); x += dpp_z<0x114, 0xf>(x); x += dpp_z<0x118, 0xf>(x);
            x += dpp_z<0x142, 0xa>(x); x += dpp_z<0x143, 0xc>(x);
            unsigned cum = x - tot, bsel = 0u, abv = 0u; bool hit = false;
#pragma unroll
            for (int k = 15; k >= 0; --k) { const unsigned prev = cum; cum += h[k]; const bool t_ = prev < (unsigned)TOPK && cum >= (unsigned)TOPK;
                bsel = t_ ? (unsigned)(lb + k) : bsel; abv = t_ ? prev : abv; hit |= t_; }
            if (hit) { info[q * 8 + 0] = bsel; info[q * 8 + 1] = abv; } }
        IX_BAR();
        { float lo[4], hi_[4];
#pragma unroll
            for (int s = 0; s < 4; ++s) { const unsigned bs = info[(2 * s + hi) * 8 + 0]; lo[s] = bs == 0u ? -INFINITY : (float)bs; hi_[s] = bs == (unsigned)(IX_NB - 1) ? INFINITY : __uint_as_float(__float_as_uint((float)(bs + 1u)) - 1u); }
#pragma unroll
            for (int i = 0; i < 16; ++i) if (wid + 8 * i < NKB) {
#pragma unroll
                for (int s = 0; s < 4; ++s) { const float v = sf[s >> 1][i][s & 1]; const float t_ = __builtin_fmaf(v, scale[s], c0[s]);
                    if (__builtin_amdgcn_fmed3f(t_, lo[s], hi_[s]) == t_) { const int q = 2 * s + hi; const unsigned pos = LDS_ADD(&info[q * 8 + 2], 1u);
                        if (pos < 64u) cand[q * 64 + pos] = (u32x2){__float_as_uint(v), (unsigned)((wid + 8 * i) * 32 + r32)}; } } } }
        IX_BAR();
        { const int q = wid; const unsigned n = info[q * 8 + 2], need = (unsigned)TOPK - info[q * 8 + 1];
            if (n <= 64u) {
                const u32x2 cv = cand[q * 64 + lane]; const bool act = (unsigned)lane < n; const float v = __uint_as_float(cv.x); const unsigned key = cv.y;
                unsigned rank = 0u;
                for (unsigned j = 0; j < n; ++j) { const float vj = __uint_as_float(__builtin_amdgcn_readlane(cv.x, j)); const unsigned kj = __builtin_amdgcn_readlane(cv.y, j);
                    rank += (vj > v || (vj == v && kj < key)) ? 1u : 0u; }
                const bool isT = act && rank == need - 1u;
                const unsigned long long mT = __ballot(isT);
                if (mT) { const int src = __builtin_ctzll(mT); const float Tv = __uint_as_float(__builtin_amdgcn_readlane(cv.x, src));
                    const unsigned long long me = __ballot(act && v == Tv);
                    if (isT) { info[q * 8 + 3] = cv.x; info[q * 8 + 4] = key; info[q * 8 + 5] = (__builtin_popcountll(me) > 1) ? 1u : 0u; } }
            } else if (lane == 0) ovf[0] = 1u;
        }
        IX_BAR();
        if (ovf[0] != 0u) {
            for (int q = 0; q < 8; ++q) {
                const unsigned n = info[q * 8 + 2];
                if (n > 64u) {
                    IX_BAR();
                    if (tid == 0) info[q * 8 + 6] = 0u;
                    IX_BAR();
                    const unsigned bstq = info[q * 8 + 0]; const float loq = bstq == 0u ? -INFINITY : (float)bstq, hiq = bstq == (unsigned)(IX_NB - 1) ? INFINITY : (float)(bstq + 1u);
                    if ((q & 1) == hi) { const int s = q >> 1;
#pragma unroll
                        for (int i = 0; i < 16; ++i) if (wid + 8 * i < NKB) {
#pragma unroll
                            for (int s2 = 0; s2 < 4; ++s2) if (s2 == s) { float c0o = c0[s2]; asm volatile("" : "+v"(c0o));
                                const float v = sf[s2 >> 1][i][s2 & 1]; const float t_ = __builtin_fmaf(v, scale[s2], c0o);
                                if (t_ >= loq && t_ < hiq) { const unsigned pos = LDS_ADD(&info[q * 8 + 6], 1u); big[pos] = (u32x2){__float_as_uint(v), (unsigned)((wid + 8 * i) * 32 + r32)}; } } } }
                    IX_BAR();
                    const unsigned need = (unsigned)TOPK - info[q * 8 + 1];
                    for (unsigned e = tid; e < n; e += 512u) { const u32x2 ce = big[e]; const float v = __uint_as_float(ce.x); unsigned rank = 0u;
                        for (unsigned j = 0; j < n; ++j) { const u32x2 cj = big[j]; const float vj = __uint_as_float(cj.x); rank += (vj > v || (vj == v && cj.y < ce.y)) ? 1u : 0u; }
                        if (rank == need - 1u) { info[q * 8 + 3] = ce.x; info[q * 8 + 4] = ce.y; info[q * 8 + 5] = 1u; } }
                    IX_BAR();
                }
            }
        }
#pragma unroll
        for (int s = 0; s < 4; ++s) { T[s] = __uint_as_float(info[(2 * s + hi) * 8 + 3]); It[s] = info[(2 * s + hi) * 8 + 4]; }
        dup = (info[5] | info[13] | info[21] | info[29] | info[37] | info[45] | info[53] | info[61]) != 0u;
    } else IX_BAR();
    { unsigned accA = 0u, accB = 0u;
#define IX_SELECT(PRED) do { _Pragma("unroll") for (int i = 0; i < 16; ++i) { const int kb = wid + 8 * i; if (kb < NKB) { const unsigned key = (unsigned)(kb * 32 + r32); (void)key; \
            _Pragma("unroll") for (int s = 0; s < 4; ++s) { const float v = sf[s >> 1][i][s & 1]; (void)v; const unsigned long long m = __ballot(PRED); \
                asm volatile("s_nop 3\n\tv_writelane_b32 %0, %2, %4\n\tv_writelane_b32 %1, %3, %4" : "+v"(accA), "+v"(accB) : "s"((unsigned)m), "s"((unsigned)(m >> 32)), "i"(4 * i + s)); } } } } while (0)
        if (N <= TOPK) IX_SELECT(true);
        else if (!dup) IX_SELECT(v >= T[s]);
        else IX_SELECT(v > T[s] || (v == T[s] && key <= It[s]));
#undef IX_SELECT
        const int kbl = wid + 8 * (lane >> 2), sl = lane & 3;
        if (kbl < NKB) { mb[(2 * sl) * 128 + kbl] = accA; mb[(2 * sl + 1) * 128 + kbl] = accB; } }
    IX_BAR();
    { const int q = tid >> 7, kbb = tid & 127; maskR[(rowg + t0 + q) * 128 + kbb] = mb[tid]; maskR[(rowg + t0 + 4 + q) * 128 + kbb] = mb[tid + 512]; }
    IX_BAR();
}
namespace spa {
typedef short s16x8_t __attribute__((ext_vector_type(8)));
constexpr int NSLOT = 3, SLOTB = 8192;
constexpr int L_K = 0, L_V = NSLOT * SLOTB, L_WS = 2 * NSLOT * SLOTB, L_OST = L_WS + 8 * 256, L_TBL = L_OST + 8 * 4096, L_MSK = L_TBL + 4096, L_END = L_MSK + 8 * 2048;
static_assert(L_END <= PHASE_LDS, "sparse attention LDS");
constexpr int TBL_OFF = 448;
#define SPA_SBAR() __builtin_amdgcn_sched_barrier(0)
#define SPA_WAIT_BAR(N) asm volatile("s_waitcnt vmcnt(" #N ") lgkmcnt(0)\n\ts_barrier" ::: "memory")
#define SPA_MFMA(a, b, c) __builtin_amdgcn_mfma_f32_32x32x16_f16(a, b, c, 0, 0, 0)
__device__ __forceinline__ void kload2(f16x8* kf, lds_cptr kp, int j) { kf[2 * j] = *(const LAS f16x8*)(kp + j * 2048); kf[2 * j + 1] = *(const LAS f16x8*)(kp + j * 2048 + 512); }
__device__ __forceinline__ float mskf(float p, int bits, int k) { return __uint_as_float(__float_as_uint(p) & (unsigned)__builtin_amdgcn_sbfe(bits, k, 1)); }
template <int K> __device__ __forceinline__ unsigned bfe1(int bits) { unsigned m; asm("v_bfe_i32 %0, %1, %2, 1" : "=v"(m) : "v"(bits), "n"(K)); return m; }

__device__ __forceinline__ void unit(int b, int h, int qb, const f16* QKV, f16* Odst, int opitch, const unsigned* maskR, const float* relb, LAS unsigned char* shm, bool build_table) {
    int tid = threadIdx.x; asm volatile("" : "+v"(tid)); const int lane = tid & 63, r32 = lane & 31, hi = lane >> 5; const int wid = __builtin_amdgcn_readfirstlane(tid >> 6);
    const size_t rowbase = (size_t)b * SEQ; const int Q0 = qb * 256, w0 = Q0 + wid * 32, NT = 4 * qb + 4;
    const f16* Qw = QKV + (rowbase + w0) * P_QKV + h * 64;
    const f16* ksrc = QKV + (rowbase + lane) * P_QKV + 512 + h * 64 + wid * 8;
    const f16* vsrc = QKV + (rowbase + 16 * (wid & 3) + (lane >> 2)) * P_QKV + 1024 + h * 64 + (wid >> 2) * 32 + (lane & 3) * 8;
    const unsigned lds0 = (unsigned)(uintptr_t)shm;
    const unsigned kdst = lds0 + L_K + wid * 1024, vdst = lds0 + L_V + wid * 1024;
#define DMA_K(t, slot) glds16(ksrc + (size_t)(t) * 64 * P_QKV, (unsigned)__builtin_amdgcn_readfirstlane(kdst + (slot)))
#define DMA_V(t, slot) glds16(vsrc + (size_t)(t) * 64 * P_QKV, (unsigned)__builtin_amdgcn_readfirstlane(vdst + (slot)))
    const unsigned* msrc = maskR + (rowbase + w0 + r32) * 128 + 4 * hi;
    const unsigned mdst = lds0 + L_MSK + wid * 2048;
#define DMA_M(g) glds16(msrc + 8 * (g), (unsigned)__builtin_amdgcn_readfirstlane(mdst + ((g) & 1) * 1024))
    const lds_cptr mrd = (lds_cptr)shm + L_MSK + wid * 2048 + r32 * 16;
#define MASK_LD(t) (*(const LAS u32x2*)(mrd + ((((t) >> 2) & 1) * 1024 + (((t) >> 1) & 1) * 512 + ((t) & 1) * 8)))
    LAS float* wsf = (LAS float*)(shm + L_WS) + wid * 64;
    LAS float* tbl = (LAS float*)(shm + L_TBL);
    if (build_table) for (int i = tid; i < 1024; i += 512) { const int rel = i - TBL_OFF, n = rel < 0 ? -rel : rel; int bk = n < 8 ? n : 2 + (31 - __builtin_clz((unsigned)(n * n))); bk = bk > 15 ? 15 : bk;
        tbl[i] = relb[((rel > 0 ? 16 : 0) + bk) * NH + h] * LOG2E; }
    const float cfar = relb[15 * NH + h] * LOG2E;
    const lds_cptr shm3 = (lds_cptr)shm; const lds_cptr kp0 = shm3 + L_K + hi * 1024 + r32 * 16;
    const lds_cptr vp0 = shm3 + L_V + ((lane >> 4) & 1) * 32 + (lane & 3) * 8 + (4 * hi + ((lane & 15) >> 2)) * 64;
    const LAS float* tb0 = tbl + (4 * hi - (w0 + r32) + TBL_OFF);
    DMA_M(0); DMA_K(0, 0); DMA_V(0, 0); DMA_K(1, SLOTB);
    f16x8 qr[4];
#pragma unroll
    for (int d0 = 0; d0 < 4; ++d0) qr[d0] = *(const f16x8*)(Qw + (size_t)r32 * P_QKV + d0 * 16 + hi * 8);
    float mhat = 0.f, l_reg = 0.f; f32x16 o[2]; o[0] = f32x16{}; o[1] = f32x16{}; f32x16 negm; { float z_ = 0.f; asm volatile("" : "+v"(z_)); _Pragma("unroll") for (int r = 0; r < 16; ++r) negm[r] = z_; }
    bool resc = false; f16x8 kf[8];
    const bool steady = (NT > 8);
#define BIAS_NEAR(P0, P1, t) do { const LAS float* tb_ = tb0 + 64 * (t); _Pragma("unroll") for (int r = 0; r < 16; ++r) { const int kc = (r & 3) + 8 * (r >> 2); P0[r] += tb_[kc]; P1[r] += tb_[32 + kc]; } } while (0)
#define RESC() do { if (resc) { asm volatile("s_waitcnt lgkmcnt(0)" ::: "memory"); \
        _Pragma("unroll") for (int d_ = 0; d_ < 2; ++d_) _Pragma("unroll") for (int r = 0; r < 16; ++r) o[d_][r] *= wsf[crow(r, hi)]; } } while (0)
    f32x16 pA0, pA1, pB0, pB1;
    int sl_prev = 0, sl_cur = 0, sl_next = SLOTB;
#define ROT() do { sl_prev = sl_cur; sl_cur = sl_next; sl_next = (sl_next == (NSLOT - 1) * SLOTB) ? 0 : sl_next + SLOTB; } while (0)
    DMA_K(2, 2 * SLOTB);
    SPA_WAIT_BAR(3);
    { const lds_cptr kb = kp0;
#pragma unroll
        for (int d0 = 0; d0 < 4; ++d0) { const f16x8 b0 = *(const LAS f16x8*)(kb + d0 * 2048), b1 = *(const LAS f16x8*)(kb + d0 * 2048 + 512);
            if (d0 == 0) { pA0 = SPA_MFMA(b0, qr[0], negm); pA1 = SPA_MFMA(b1, qr[0], negm); } else { pA0 = SPA_MFMA(b0, qr[d0], pA0); pA1 = SPA_MFMA(b1, qr[d0], pA1); } }
        asm volatile("s_nop 15\n\ts_nop 7" : "+v"(pA0), "+v"(pA1));
        if (qb == 0) BIAS_NEAR(pA0, pA1, 0);
        else {
#pragma unroll
            for (int r = 0; r < 16; ++r) { pA0[r] += cfar; pA1[r] += cfar; } }
        const float rm = rowmax32(pA0, pA1); mhat = rm; const float cb = steady ? cfar : 0.f;
#pragma unroll
        for (int r = 0; r < 16; ++r) negm[r] = cb - mhat;
        asm volatile("" : "+v"(negm));
        const u32x2 mw = MASK_LD(0); const int mlo = (int)(mw.x >> (4 * hi)), mhi = (int)(mw.y >> (4 * hi));
#pragma unroll
        for (int r = 0; r < 16; ++r) { const int kc = (r & 3) + 8 * (r >> 2); pA0[r] = mskf(__builtin_amdgcn_exp2f(pA0[r] - rm), mlo, kc); pA1[r] = mskf(__builtin_amdgcn_exp2f(pA1[r] - rm), mhi, kc); }
    }
    SPA_WAIT_BAR(0);
    if (NT > 4) DMA_M(1);
    DMA_K(3, 0); DMA_V(1, SLOTB);
    ROT();
    { const lds_cptr kp = kp0 + sl_cur; kf[0] = *(const LAS f16x8*)(kp); kf[1] = *(const LAS f16x8*)(kp + 512); kf[2] = *(const LAS f16x8*)(kp + 2048); kf[3] = *(const LAS f16x8*)(kp + 2560);
      kf[4] = *(const LAS f16x8*)(kp + 4096); kf[5] = *(const LAS f16x8*)(kp + 4608); kf[6] = *(const LAS f16x8*)(kp + 6144); kf[7] = *(const LAS f16x8*)(kp + 6656); }
    SPA_WAIT_BAR(2);
    s16x4 vlo[8], vhi[8]; u32x4 pw0, pw1, pw2, pw3;
#define PKW(P, B) pk2h(P[B], P[B + 1])
#define PAF(k) __builtin_bit_cast(f16x8, pw##k)
#define VFR(i) __builtin_bit_cast(f16x8, (s16x8_t){vlo[i][0], vlo[i][1], vlo[i][2], vlo[i][3], vhi[i][0], vhi[i][1], vhi[i][2], vhi[i][3]})
#define PIN(x) asm volatile("" : "+v"(x))
#define MX3(a, b, c) __builtin_fmaxf(__builtin_fmaxf((a), (b)), (c))
#define PR2(P, i) __builtin_shufflevector(P, P, i, (i) + 1)
#define GAPA(MF, PA, ia, PB, ib, W0, W1, PW) do { MF; sacc += PR2(PA, ia); if ((ib) >= 0) sacc += PR2(PB, (ib) < 0 ? 0 : (ib)); PIN(sacc); W0; W1; PIN(PW); SPA_SBAR(); } while (0)
#define KC_(B) (((B) & 3) + 8 * ((B) >> 2))
#define GAPB(MF, X, B, MW) do { MF; const float e0_ = __builtin_amdgcn_exp2f(X[B]), e1_ = __builtin_amdgcn_exp2f(X[(B) + 1]), e2_ = __builtin_amdgcn_exp2f(X[(B) + 2]), e3_ = __builtin_amdgcn_exp2f(X[(B) + 3]); \
        const unsigned m0_ = bfe1<KC_(B)>(MW), m1_ = bfe1<KC_((B) + 1)>(MW), m2_ = bfe1<KC_((B) + 2)>(MW), m3_ = bfe1<KC_((B) + 3)>(MW); \
        X[B] = __uint_as_float(__float_as_uint(e0_) & m0_); X[(B) + 1] = __uint_as_float(__float_as_uint(e1_) & m1_); X[(B) + 2] = __uint_as_float(__float_as_uint(e2_) & m2_); X[(B) + 3] = __uint_as_float(__float_as_uint(e3_) & m3_); \
        PIN(X); SPA_SBAR(); } while (0)
#define VRD(i) do { vlo[i] = vtr(vp_ + (((i) >> 2) * 4096 + ((i) & 3) * 1024)); vhi[i] = vtr(vp_ + (((i) >> 2) * 4096 + ((i) & 3) * 1024 + 512)); } while (0)
#define KRD(G, j) do { if (G) { kload2(kf, kp0 + sl_next, j); SPA_SBAR(); } } while (0)
#define STEP(C0, C1, P0, P1, t, GK, GV, GL, NEAR, CB) do { SPA_SBAR(); \
    const lds_cptr vp_ = vp0 + sl_prev; const u32x2 mw_ = MASK_LD(t); const int mlo_ = (int)(mw_.x >> (4 * hi)), mhi_ = (int)(mw_.y >> (4 * hi)); \
    VRD(0); SPA_SBAR(); f32x2 sacc = (f32x2){P0[0], P0[1]}; \
    GAPA(C0 = SPA_MFMA(kf[0], qr[0], negm), P0, 2, P0, 4,     pw0[0] = PKW(P0, 0), pw0[1] = PKW(P0, 2), pw0); \
    VRD(4); SPA_SBAR(); GAPA(C1 = SPA_MFMA(kf[1], qr[0], negm), P0, 6, P0, 8,     pw0[2] = PKW(P0, 4), pw0[3] = PKW(P0, 6), pw0); \
    VRD(1); SPA_SBAR(); GAPA(C0 = SPA_MFMA(kf[2], qr[1], C0),   P0, 10, P0, 12, pw1[0] = PKW(P0, 8), pw1[1] = PKW(P0, 10), pw1); \
    VRD(5); SPA_SBAR(); GAPA(C1 = SPA_MFMA(kf[3], qr[1], C1),   P0, 14, P1, 0,   pw1[2] = PKW(P0, 12), pw1[3] = PKW(P0, 14), pw1); \
    VRD(2); SPA_SBAR(); GAPA(C0 = SPA_MFMA(kf[4], qr[2], C0),   P1, 2, P1, 4,     pw2[0] = PKW(P1, 0), pw2[1] = PKW(P1, 2), pw2); \
    VRD(6); SPA_SBAR(); GAPA(C1 = SPA_MFMA(kf[5], qr[2], C1),   P1, 6, P1, 8,     pw2[2] = PKW(P1, 4), pw2[3] = PKW(P1, 6), pw2); \
    VRD(3); SPA_SBAR(); GAPA(C0 = SPA_MFMA(kf[6], qr[3], C0),   P1, 10, P1, 12, pw3[0] = PKW(P1, 8), pw3[1] = PKW(P1, 10), pw3); \
    VRD(7); SPA_SBAR(); GAPA(C1 = SPA_MFMA(kf[7], qr[3], C1),   P1, 14, P1, -1,       pw3[2] = PKW(P1, 12), pw3[3] = PKW(P1, 14), pw3); \
    l_reg += sacc.x + sacc.y; \
    if ((((t) & 3) == 0) && ((t) + 4 < NT)) { DMA_M(((t) >> 2) + 1); } \
    if (GK) { DMA_K((t) + 3, sl_cur); } if (GV) { DMA_V((t) + 1, sl_next); } \
    if (NEAR) { asm volatile("s_nop 15\n\ts_nop 7" : "+v"(C0), "+v"(C1)); BIAS_NEAR(C0, C1, t); } \
    { float a = MX3(C0[0], C0[1], C1[0]), bq = MX3(C0[2], C0[3], C1[1]); a = MX3(a, C1[2], C1[3]); \
      _Pragma("unroll") for (int r = 4; r < 16; r += 4) { a = MX3(a, C0[r], C0[r + 1]); bq = MX3(bq, C0[r + 2], C0[r + 3]); a = MX3(a, C1[r], C1[r + 1]); bq = MX3(bq, C1[r + 2], C1[r + 3]); } \
      float rm = __builtin_fmaxf(a, bq); { auto rr = __builtin_amdgcn_permlane32_swap(__float_as_uint(rm), __float_as_uint(rm), false, false); rm = __builtin_fmaxf(__uint_as_float(rr[0]), __uint_as_float(rr[1])); } \
      resc = false; \
      if (__builtin_expect(__any(rm > 8.0f), 0)) { const float dl = __builtin_fmaxf(rm, 0.f); mhat += dl; \
        _Pragma("unroll") for (int r = 0; r < 16; ++r) { C0[r] -= dl; C1[r] -= dl; } \
        _Pragma("unroll") for (int r = 0; r < 16; ++r) negm[r] = (CB) - mhat; asm volatile("" : "+v"(negm)); \
        const float f = __builtin_amdgcn_exp2f(-dl); l_reg *= f; if (hi == 0) wsf[r32] = f; resc = true; } } \
    SPA_SBAR(); \
    GAPB(o[0] = SPA_MFMA(PAF(0), VFR(0), o[0]), C0, 0, mlo_); \
    GAPB(o[1] = SPA_MFMA(PAF(0), VFR(4), o[1]), C0, 4, mlo_); \
    KRD(GL, 0); GAPB(o[0] = SPA_MFMA(PAF(1), VFR(1), o[0]), C0, 8, mlo_); \
    KRD(GL, 1); GAPB(o[1] = SPA_MFMA(PAF(1), VFR(5), o[1]), C0, 12, mlo_); \
    KRD(GL, 2); GAPB(o[0] = SPA_MFMA(PAF(2), VFR(2), o[0]), C1, 0, mhi_); \
    KRD(GL, 3); GAPB(o[1] = SPA_MFMA(PAF(2), VFR(6), o[1]), C1, 4, mhi_); \
    GAPB(o[0] = SPA_MFMA(PAF(3), VFR(3), o[0]), C1, 8, mhi_); \
    GAPB(o[1] = SPA_MFMA(PAF(3), VFR(7), o[1]), C1, 12, mhi_); \
    } while (0)
    int t = 1;
    for (; t + 7 < NT; t += 2) {
        STEP(pB0, pB1, pA0, pA1, t, true, true, true, false, cfar);     SPA_WAIT_BAR(2); RESC(); ROT();
        STEP(pA0, pA1, pB0, pB1, t + 1, true, true, true, false, cfar); SPA_WAIT_BAR(2); RESC(); ROT();
    }
    if (steady) {
#pragma unroll
        for (int r = 0; r < 16; ++r) negm[r] = -mhat;
        asm volatile("" : "+v"(negm)); }
#define ENDW(tt) do { if ((tt) + 3 < NT) { SPA_WAIT_BAR(2); } else if ((tt) + 2 < NT) { SPA_WAIT_BAR(1); } else { SPA_WAIT_BAR(0); } } while (0)
    for (; t + 1 < NT; t += 2) {
        STEP(pB0, pB1, pA0, pA1, t, (t + 3 < NT), (t + 1 < NT), (t + 1 < NT), true, 0.f);         ENDW(t);     RESC(); ROT();
        STEP(pA0, pA1, pB0, pB1, t + 1, (t + 4 < NT), (t + 2 < NT), (t + 2 < NT), true, 0.f);     ENDW(t + 1); RESC(); ROT();
    }
    STEP(pB0, pB1, pA0, pA1, NT - 1, false, false, false, true, 0.f); RESC();
    { float sacc = pB0[0] + pB0[1];
#pragma unroll
        for (int r = 2; r < 16; ++r) sacc += pB0[r];
#pragma unroll
        for (int r = 0; r < 16; ++r) sacc += pB1[r];
        l_reg += sacc;
        u32x4 pw[4];
#pragma unroll
        for (int k = 0; k < 4; ++k) { pw[0][k] = pk2h(pB0[2 * k], pB0[2 * k + 1]); pw[1][k] = pk2h(pB0[8 + 2 * k], pB0[9 + 2 * k]); pw[2][k] = pk2h(pB1[2 * k], pB1[2 * k + 1]); pw[3][k] = pk2h(pB1[8 + 2 * k], pB1[9 + 2 * k]); }
        SPA_SBAR(); pv_tile(o, vp0 + sl_cur, pw); }
    { auto rr = __builtin_amdgcn_permlane32_swap(__float_as_uint(l_reg), __float_as_uint(l_reg), false, false); l_reg = __uint_as_float(rr[0]) + __uint_as_float(rr[1]); }
    if (hi == 0) wsf[32 + r32] = l_reg;
    asm volatile("s_waitcnt lgkmcnt(0)" ::: "memory");
    float rli[16];
#pragma unroll
    for (int r = 0; r < 16; ++r) rli[r] = __builtin_amdgcn_rcpf(wsf[32 + crow(r, hi)]);
    store_o(o, rli, (LAS f16*)(shm + L_OST) + wid * 2048, Odst + (rowbase + w0) * opitch + h * 64, opitch, lane);
    asm volatile("s_waitcnt lgkmcnt(0)\n\ts_barrier" ::: "memory");
#undef DMA_K
#undef DMA_V
#undef DMA_M
#undef MASK_LD
#undef BIAS_NEAR
#undef RESC
#undef ROT
#undef PKW
#undef PAF
#undef VFR
#undef PIN
#undef MX3
#undef GAPA
#undef PR2
#undef KC_
#undef GAPB
#undef VRD
#undef KRD
#undef STEP
#undef ENDW
}
}
#ifndef REP_GEMM
#define REP_GEMM 1
#endif
#ifndef REP_G_IN
#define REP_G_IN REP_GEMM
#endif
#ifndef REP_G_BR
#define REP_G_BR REP_GEMM
#endif
#ifndef REP_G_WO
#define REP_G_WO REP_GEMM
#endif
#ifndef REP_G_GU
#define REP_G_GU REP_GEMM
#endif
#ifndef REP_G_DN
#define REP_G_DN REP_GEMM
#endif
#ifndef REP_IDX
#define REP_IDX 1
#endif
#ifndef REP_SB
#define REP_SB 1
#endif
#ifndef REP_SP
#define REP_SP 1
#endif
#ifndef REP_NORM
#define REP_NORM 1
#endif
struct Args { const float* in[12]; float* out; unsigned char* ws; };
__global__ void __launch_bounds__(512, 2) fwd_kernel(Args args) {
    extern __shared__ __attribute__((aligned(16))) unsigned char lds_raw[];
    Frame F;
    F.lds = (LAS unsigned char*)lds_raw;
    F.MISC = (volatile LAS unsigned*)(F.lds + MISC_OFF);
    F.tid = threadIdx.x; F.lane = F.tid & 63; F.wave = __builtin_amdgcn_readfirstlane(F.tid >> 6);
    F.G = gridDim.x; { const int bx = blockIdx.x; F.vcu = (F.G % 8 == 0) ? (bx % 8) * (F.G / 8) + bx / 8 : bx; }
    GAS unsigned char* wsg = (GAS unsigned char*)args.ws;
    unsigned char* ws0 = (unsigned char*)wsg;
    F.ctl = (unsigned*)(ws0 + WS_CTL);
    if (F.tid < (LDS_BYTES - PHASE_LDS) / 4) ((LAS unsigned*)(F.lds + PHASE_LDS))[F.tid] = 0u;
    __syncthreads();
    XcdBarrier bar = xcd_barrier_post(F.ctl + CW_BAR, F.MISC + 8);
    Inputs I; I.x = args.in[0]; I.w_in = args.in[1]; I.w_a = args.in[2]; I.w_b = args.in[3]; I.w_o = args.in[4]; I.w_gu = args.in[5]; I.w_d = args.in[6];
    I.g_pre_mix = args.in[7]; I.g_post_mix = args.in[8]; I.g_pre_ffn = args.in[9]; I.g_post_ffn = args.in[10]; I.rel_bias = args.in[11];
    float* X = args.out;
    const int vcu = F.vcu;

    convert_weights(F, I, ws0, 0);
    norm_to_f16(F, I.x, I.g_pre_mix, (f16*)(ws0 + WS_H), ws0 + WS_H8);
    xcd_barrier(bar);

    for (int l = 0; l < DEPTH; ++l) {
        asm volatile("" : "+s"(wsg)); unsigned char* ws = (unsigned char*)wsg;
        f16* H = (f16*)(ws + WS_H); f16* QKVA = (f16*)(ws + WS_QKVA); f16* QI = (f16*)(ws + WS_QI); f16* KIW = (f16*)(ws + WS_KIW); f16* WIB = (f16*)(ws + WS_WI); f16* QKVB = (f16*)(ws + WS_QKVB);
        f16* GATES = (f16*)(ws + WS_GATES); f16* Y = (f16*)(ws + WS_GATES); unsigned* MASK = (unsigned*)(ws + WS_MASK); f16* HID = (f16*)(ws + WS_HID);
        const unsigned char* wt = ws + WS_WT;
        unsigned char* H8 = ws + WS_H8;
        f16* XA = (f16*)(ws + WS_QKVB); f16* XB = (f16*)X;
        { pg8::Gemm g{H, (const f16*)(wt + WT_IN), M, NIN16, DM, DM, nullptr, 0}; pg8::StaticOrder S; S.init(M, NIN16, F.G, (int)blockIdx.x);
          pg8::EpiProj E{QKVA, QI, KIW, WIB, QKVB};
          for (int rep = 0; rep < REP_G_IN; ++rep) pg8::gemm_phase<pg8::EpiProj, true>(F.lds, g, S, E); }
        { pg8::Gemm g{(const f16*)H8, (const f16*)(wt + WT_G8), M, 2048, DM / 2, DM / 2, nullptr, 0}; pg8::GateOrder S{(int)blockIdx.x};
          pg8::EpiGates8 E{GATES};
          for (int rep = 0; rep < REP_G_IN; ++rep) pg8::gemm_phase_t<pg8::EpiGates8, true, true, pg8::GateOrder>(F.lds, g, S, E); }
        xcd_barrier(bar);
        { const int b = vcu >> 5, r = vcu & 31;
          f16x8 aq[2][4]; f16x8 wq[2][2];
          for (int rep = 0; rep < REP_IDX; ++rep) { indexer_front(b, r, QI, KIW, WIB, F.lds, aq, wq);
            for (int k = 0; k < 16; ++k) { const int kn = k + 1; indexer_unit(b, 32 * k + ((k & 1) ? 31 - r : r), QI, KIW, WIB, MASK, F.lds, aq, wq, kn < 16, b, 32 * kn + ((kn & 1) ? 31 - r : r)); } } }
        { const int bh = vcu >> 2, s = vcu & 3;
          for (int rep = 0; rep < REP_SB; ++rep) for (int k = 0; k < 4; ++k) { const int qb = (k == 0) ? s : (k == 1) ? 7 - s : (k == 2) ? 8 + s : 15 - s;
            if (rep + 1 < REP_SB) sbattn_unit(bh >> 3, bh & 7, qb, QKVB, H, 512, F.lds); else sbattn_unit(bh >> 3, bh & 7, qb, QKVB, QKVB, P_QKV, F.lds); } }
        xcd_barrier(bar);
        { const int bh = vcu >> 2, s = vcu & 3;
          for (int rep = 0; rep < REP_SP; ++rep) for (int k = 0; k < 4; ++k) { const int qb = (k == 0) ? s : (k == 1) ? 7 - s : (k == 2) ? 8 + s : 15 - s;
            if (rep + 1 < REP_SP) spa::unit(bh >> 3, bh & 7, qb, QKVA, H, 512, MASK, I.rel_bias, F.lds, k == 0); else spa::unit(bh >> 3, bh & 7, qb, QKVA, QKVA, P_QKV, MASK, I.rel_bias, F.lds, k == 0); } }
        xcd_barrier(bar);
        for (int rep = 0; rep < REP_G_BR; ++rep) { pg8::StaticOrder S; S.init(M, DM, F.G, (int)blockIdx.x);
          pg8::Gemm g{QKVA, (const f16*)(wt + WT_A), M, DM, DM, P_QKV, QKVB, 8}; pg8::EpiGateMerged E{H, GATES}; pg8::gemm_phase<pg8::EpiGateMerged, true>(F.lds, g, S, E); }
        xcd_barrier(bar);
        { pg8::Gemm g{H, (const f16*)(wt + WT_O), M, DM, DM, DM, nullptr, 0}; pg8::StaticOrder S; S.init(M, DM, F.G, (int)blockIdx.x);
          pg8::EpiF16 E{Y, DM}; for (int rep = 0; rep < REP_G_WO; ++rep) pg8::gemm_phase<pg8::EpiF16, true>(F.lds, g, S, E); }
        xcd_barrier(bar);
        if (l == 0) norm_residual<false, true>(F, I.x, Y, I.g_post_mix + l * DM, XA, I.g_pre_ffn + l * DM, H, nullptr);
        else norm_residual<true, true>(F, XB, Y, I.g_post_mix + l * DM, XA, I.g_pre_ffn + l * DM, H, nullptr);
        xcd_barrier(bar);
        { pg8::Gemm g{H, (const f16*)(wt + WT_GU), M, NGU, DM, DM, nullptr, 0}; pg8::StaticOrder S; S.init(M, NGU, F.G, (int)blockIdx.x);
          pg8::EpiSwiglu8 E{(unsigned char*)HID}; for (int rep = 0; rep < REP_G_GU; ++rep) pg8::gemm_phase<pg8::EpiSwiglu8, true>(F.lds, g, S, E); }
        xcd_barrier(bar);
        { pg8::Gemm g{HID, (const f16*)(wt + WT_D), M, DM, DFF / 2, DFF / 2, nullptr, 0}; pg8::StaticOrder S; S.init(M, DM, F.G, (int)blockIdx.x);
          pg8::EpiF16S E{Y, DM, 1.0f / (pg8::HID_SCALE * pg8::WD_SCALE)}; for (int rep = 0; rep < REP_G_DN; ++rep) pg8::gemm_phase<pg8::EpiF16S, true, true>(F.lds, g, S, E); }
        xcd_barrier(bar);
        if (l + 1 < DEPTH) { norm_residual<true, true>(F, XA, Y, I.g_post_ffn + l * DM, XB, I.g_pre_mix + (l + 1) * DM, H, H8); convert_weights(F, I, ws, l + 1); xcd_barrier(bar); }
        else norm_residual<true, false>(F, XA, Y, I.g_post_ffn + l * DM, X, nullptr, nullptr, nullptr);
    }
}

extern "C" void kernel_launch(void* const* d_in, const int* in_sizes, int n_in, void* d_out, int out_size, void* d_ws, size_t ws_size, hipStream_t stream) {
    static int grid = 0;
    if (grid == 0) {
        if (n_in != 12 || out_size != M * DM || ws_size < WS_END) { fprintf(stderr, "kernel_launch: unexpected shapes (n_in %d, out %d, ws %zu); nothing launched\n", n_in, out_size, ws_size); grid = -1; return; }
        int dev = 0, cus = 0, per_cu = 0;
        if (hipGetDevice(&dev) != hipSuccess || hipDeviceGetAttribute(&cus, hipDeviceAttributeMultiprocessorCount, dev) != hipSuccess) { grid = -1; return; }
        if (hipFuncSetAttribute((const void*)fwd_kernel, hipFuncAttributeMaxDynamicSharedMemorySize, LDS_BYTES) != hipSuccess) { fprintf(stderr, "kernel_launch: hipFuncSetAttribute failed\n"); grid = -1; return; }
        if (hipOccupancyMaxActiveBlocksPerMultiprocessor(&per_cu, (const void*)fwd_kernel, 512, LDS_BYTES) != hipSuccess || per_cu < 1) fprintf(stderr, "kernel_launch: occupancy query reports %d workgroups per CU\n", per_cu);
        (void)hipGetLastError();
        if (cus < 256) { fprintf(stderr, "kernel_launch: %d CUs; this kernel's unit deals need 256 co-resident workgroups; nothing launched\n", cus); grid = -1; return; }
        grid = 256;
    }
    if (grid < 0) return;
    if (hipMemsetAsync((char*)d_ws + WS_CTL, 0, CTL_ZERO_BYTES, stream) != hipSuccess) return;
    Args a{};
    for (int i = 0; i < 12; ++i) a.in[i] = (const float*)d_in[i];
    a.out = (float*)d_out; a.ws = (unsigned char*)d_ws;
    hipLaunchKernelGGL(fwd_kernel, dim3(grid), dim3(512), LDS_BYTES, stream, a);
}
```
